# Optimizing an MI355X kernel written in HIP

```python
import math
import jax, jax.numpy as jnp
from jax import lax
import numpy as np

D_MODEL = 4096
BATCH = 2
SEQ = 4096
DEPTH = 2

D_SSM = D_MODEL // 2
SSM_GROUP = 16
N_GROUPS = D_SSM // SSM_GROUP
STATE = 64
DT_MIN = 1e-3
DT_MAX = 1e-1
HEAD_DIM = 128
D_ATTN = D_MODEL // 2
N_HEADS = D_ATTN // (2 * HEAD_DIM)
Q_BLOCK = 128
SUBLN_EPS = 1e-5
N_BUCKETS = 32
MAX_DISTANCE = 128
EPS = 1e-6
N_IN = 2 * D_SSM + 4 * D_ATTN + 2 * D_MODEL
NEG_INF = -1e30

kernel_name = 'hybrid_s5_diffattn_adaln_block'


def rms_norm(x, g, eps):
    xf = x.astype(jnp.float32)
    return xf * lax.rsqrt(jnp.mean(xf * xf, axis=-1, keepdims=True) + eps) * g.astype(jnp.float32)


def _complex_affine_combine(e1, e2):
    a1r, a1i, b1r, b1i = e1
    a2r, a2i, b2r, b2i = e2
    ar = a2r * a1r - a2i * a1i
    ai = a2r * a1i + a2i * a1r
    br = a2r * b1r - a2i * b1i + b2r
    bi = a2r * b1i + a2i * b1r + b2i
    return (ar, ai, br, bi)


def s5_mixer(u, lam_re, lam_im, log_dt, b_re, b_im, c_re, c_im, d_skip, w_glu):
    bsz, seq, _ = u.shape
    uf = u.astype(jnp.float32).reshape(bsz, seq, N_GROUPS, SSM_GROUP)
    lr = lam_re.astype(jnp.float32)
    li = lam_im.astype(jnp.float32)
    dt = jnp.exp(log_dt.astype(jnp.float32))[:, None]
    mag = jnp.exp(lr * dt)
    ab_re = mag * jnp.cos(li * dt)
    ab_im = mag * jnp.sin(li * dt)
    den = lr * lr + li * li
    num_re = ab_re - 1.0
    coef_re = (num_re * lr + ab_im * li) / den
    coef_im = (ab_im * lr - num_re * li) / den
    br = b_re.astype(jnp.float32)
    bi = b_im.astype(jnp.float32)
    bb_re = coef_re[..., None] * br - coef_im[..., None] * bi
    bb_im = coef_re[..., None] * bi + coef_im[..., None] * br
    x_re = jnp.einsum('gpc,bsgc->bsgp', bb_re, uf)
    x_im = jnp.einsum('gpc,bsgc->bsgp', bb_im, uf)
    a_re = jnp.broadcast_to(ab_re, x_re.shape)
    a_im = jnp.broadcast_to(ab_im, x_im.shape)
    _, _, h_re, h_im = lax.associative_scan(_complex_affine_combine, (a_re, a_im, x_re, x_im), axis=1)
    y = (jnp.einsum('gcp,bsgp->bsgc', c_re.astype(jnp.float32), h_re)
         - jnp.einsum('gcp,bsgp->bsgc', c_im.astype(jnp.float32), h_im)
         + d_skip.astype(jnp.float32) * uf)
    y = y.reshape(bsz, seq, D_SSM)
    g = jax.nn.gelu(y)
    return g * jax.nn.sigmoid(g @ w_glu.astype(jnp.float32))


def t5_bucket(rel):
    n = jnp.maximum(rel, 0)
    max_exact = N_BUCKETS // 2
    nf = jnp.maximum(n, 1).astype(jnp.float32)
    large = max_exact + (jnp.log(nf / max_exact) / math.log(MAX_DISTANCE / max_exact)
                         * (N_BUCKETS - max_exact)).astype(jnp.int32)
    large = jnp.minimum(large, N_BUCKETS - 1)
    return jnp.where(n < max_exact, n, large)


def diff_attention(q, k, v, rel_bias, lam, lam_init, subln_g):
    bsz, seq = q.shape[0], q.shape[1]
    q = q.astype(jnp.float32) * (HEAD_DIM ** -0.5)
    k = k.astype(jnp.float32)
    v = v.astype(jnp.float32)
    table = rel_bias.astype(jnp.float32)
    k_pos = jnp.arange(seq)

    def block(i):
        start = i * Q_BLOCK
        qb = lax.dynamic_slice_in_dim(q, start, Q_BLOCK, axis=1)
        s = jnp.einsum('bqhmd,bkhmd->bhmqk', qb, k)
        rel = (start + jnp.arange(Q_BLOCK))[:, None] - k_pos[None, :]
        bias = jnp.transpose(table[t5_bucket(rel)], (2, 0, 1))
        s = jnp.where(rel[None, None, None] >= 0, s + bias[None, :, None], NEG_INF)
        p = jax.nn.softmax(s, axis=-1)
        attn = p[:, :, 0] - lam * p[:, :, 1]
        return jnp.einsum('bhqk,bkhd->bqhd', attn, v)

    o = lax.map(block, jnp.arange(seq // Q_BLOCK))
    o = jnp.moveaxis(o, 0, 1).reshape(bsz, seq, N_HEADS, 2 * HEAD_DIM)
    o = rms_norm(o, subln_g, SUBLN_EPS) * (1.0 - lam_init)
    return o.reshape(bsz, seq, D_ATTN)


def setup_inputs(seed: int = 0) -> dict:
    key = jax.random.key(seed)
    ks = jax.random.split(key, 32)
    f32 = jnp.float32

    def nrm(k, shape, scale):
        return jax.random.normal(k, shape, f32) * scale

    L = DEPTH
    lam_re = -0.5 + nrm(ks[6], (L, N_GROUPS, STATE), 0.01)
    lam_im = (math.pi * jnp.arange(STATE, dtype=f32))[None, None, :] + nrm(ks[7], (L, N_GROUPS, STATE), 0.01)
    log_dt = jax.random.uniform(ks[8], (L, N_GROUPS), f32, math.log(DT_MIN), math.log(DT_MAX))
    return {
        'x': nrm(ks[0], (BATCH, SEQ, D_MODEL), 1.0),
        'c': nrm(ks[1], (BATCH, D_MODEL), 1.0),
        'norm_g': 1.0 + nrm(ks[2], (L, D_MODEL), 0.02),
        'w_ada': nrm(ks[3], (L, D_MODEL, 3 * D_MODEL), 0.5 * D_MODEL ** -0.5),
        'b_ada': nrm(ks[4], (L, 3 * D_MODEL), 0.02),
        'w_in': nrm(ks[5], (L, D_MODEL, N_IN), D_MODEL ** -0.5),
        'ssm_lambda_re': lam_re,
        'ssm_lambda_im': lam_im,
        'ssm_log_dt': log_dt,
        'ssm_b_re': nrm(ks[9], (L, N_GROUPS, STATE, SSM_GROUP), (0.5 / SSM_GROUP) ** 0.5),
        'ssm_b_im': nrm(ks[10], (L, N_GROUPS, STATE, SSM_GROUP), (0.5 / SSM_GROUP) ** 0.5),
        'ssm_c_re': nrm(ks[11], (L, N_GROUPS, SSM_GROUP, STATE), (0.5 / STATE) ** 0.5),
        'ssm_c_im': nrm(ks[12], (L, N_GROUPS, SSM_GROUP, STATE), (0.5 / STATE) ** 0.5),
        'ssm_d': nrm(ks[13], (L, N_GROUPS, SSM_GROUP), 1.0),
        'w_glu': nrm(ks[14], (L, D_SSM, D_SSM), D_SSM ** -0.5),
        'lambda_q1': nrm(ks[15], (L, HEAD_DIM), 0.1),
        'lambda_k1': nrm(ks[16], (L, HEAD_DIM), 0.1),
        'lambda_q2': nrm(ks[17], (L, HEAD_DIM), 0.1),
        'lambda_k2': nrm(ks[18], (L, HEAD_DIM), 0.1),
        'subln_g': 1.0 + nrm(ks[19], (L, 2 * HEAD_DIM), 0.02),
        'w_out_ssm': nrm(ks[20], (L, D_SSM, D_MODEL), D_SSM ** -0.5),
        'w_out_attn': nrm(ks[21], (L, D_ATTN, D_MODEL), D_ATTN ** -0.5),
        'w_o': nrm(ks[22], (L, D_MODEL, D_MODEL), D_MODEL ** -0.5),
        'rel_bias': nrm(ks[23], (N_BUCKETS, N_HEADS), 0.5),
        'final_g': 1.0 + nrm(ks[24], (D_MODEL,), 0.02),
    }


def reference(x, c, norm_g, w_ada, b_ada, w_in, ssm_lambda_re, ssm_lambda_im, ssm_log_dt,
              ssm_b_re, ssm_b_im, ssm_c_re, ssm_c_im, ssm_d, w_glu,
              lambda_q1, lambda_k1, lambda_q2, lambda_k2, subln_g,
              w_out_ssm, w_out_attn, w_o, rel_bias, final_g):
    out_dtype = x.dtype
    bsz, seq, _ = x.shape
    widths = [D_SSM, D_SSM, D_ATTN, D_ATTN, D_ATTN, D_ATTN, D_MODEL, D_MODEL]
    offsets = [sum(widths[:i + 1]) for i in range(len(widths) - 1)]
    c_act = jax.nn.silu(c.astype(jnp.float32))
    h_res = x.astype(jnp.float32)
    for l in range(DEPTH):
        mod = c_act @ w_ada[l].astype(jnp.float32) + b_ada[l].astype(jnp.float32)
        shift, scale, gate = jnp.split(mod[:, None, :], 3, axis=-1)
        h = rms_norm(h_res, norm_g[l], EPS) * (1.0 + scale) + shift
        proj = h @ w_in[l].astype(jnp.float32)
        u_s, z_s, q, k, v, z_a, g_s, g_a = jnp.split(proj, offsets, axis=-1)
        y_s = s5_mixer(u_s, ssm_lambda_re[l], ssm_lambda_im[l], ssm_log_dt[l], ssm_b_re[l], ssm_b_im[l],
                       ssm_c_re[l], ssm_c_im[l], ssm_d[l], w_glu[l]) * jax.nn.silu(z_s)
        p_s = y_s @ w_out_ssm[l].astype(jnp.float32)
        lam_init = 0.8 - 0.6 * math.exp(-0.3 * l)
        lam = (jnp.exp(jnp.sum(lambda_q1[l].astype(jnp.float32) * lambda_k1[l].astype(jnp.float32)))
               - jnp.exp(jnp.sum(lambda_q2[l].astype(jnp.float32) * lambda_k2[l].astype(jnp.float32)))
               + lam_init)
        qh = q.reshape(bsz, seq, N_HEADS, 2, HEAD_DIM)
        kh = k.reshape(bsz, seq, N_HEADS, 2, HEAD_DIM)
        vh = v.reshape(bsz, seq, N_HEADS, 2 * HEAD_DIM)
        y_a = diff_attention(qh, kh, vh, rel_bias, lam, lam_init, subln_g[l]) * jax.nn.silu(z_a)
        p_a = y_a @ w_out_attn[l].astype(jnp.float32)
        merged = jax.nn.sigmoid(g_s) * p_s + jax.nn.sigmoid(g_a) * p_a
        h_res = h_res + gate * (merged @ w_o[l].astype(jnp.float32))
    return rms_norm(h_res, final_g, EPS).astype(out_dtype)
```

```cpp
#include <hip/hip_runtime.h>
#include <cstdio>
#include <cstdint>
#include <cmath>
namespace pg8 {
#define PG8_LAS __attribute__((address_space(3)))
typedef unsigned short bf16_t;
typedef short bf16x8 __attribute__((ext_vector_type(8)));
typedef float f32x4 __attribute__((ext_vector_type(4)));
typedef unsigned u32x4 __attribute__((ext_vector_type(4)));
constexpr int BM = 256, BK = 64, HALF = 128, HTB = HALF * BK * 2  , STAGE_BYTES = 8 * HTB, NXCD = 8, WGM = 8;

__host__ __device__ __forceinline__ int lds_byte(int r, int c) { const int st = (r >> 4) * 2 + (c >> 5), rr = r & 15, cc = c & 31, ob = rr * 64 + cc * 2; return st * 1024 + (ob ^ (((ob >> 9) & 1) << 5)); }
__host__ __device__ __forceinline__ void stage_rc(int b, int& R, int& C) { const int st = b / 1024, sb = b % 1024, swz = sb ^ (((sb >> 9) & 1) << 5); R = (st >> 1) * 16 + swz / 64; C = (st & 1) * 32 + (swz % 64) / 2; }
__host__ __device__ __forceinline__ int perm32(int rho) { const int n = rho >> 4, i = rho & 15; return 8 * (i >> 2) + 4 * n + (i & 3); }

struct Unit { int pm, pn; };
struct Gemm { const bf16_t* A; const bf16_t* Bt; int M, N, K; };

struct StaticOrder {
    int nM, nN, nwg, G, c;
    __host__ __device__ void init(int M, int N, int G_, int c_) { nM = M / BM; nN = N / BM; nwg = nM * nN; G = G_; c = c_; }
    __host__ __device__ bool next(int i, Unit& u) const {
        const long L = (long)i * G + c; if (L >= nwg) return false;
        int wgid = (int)L; { const int q = nwg / NXCD, r = nwg % NXCD, xcd = wgid % NXCD, off = wgid / NXCD; wgid = (xcd < r ? xcd * (q + 1) : r * (q + 1) + (xcd - r) * q) + off; }
        const int nig = WGM * nN, gid = wgid / nig, fm = gid * WGM, gsz = (nM - fm) < WGM ? (nM - fm) : WGM;
        u.pm = fm + ((wgid % nig) % gsz); u.pn = (wgid % nig) / gsz; return true;
    }
    __device__ __forceinline__ void a_ready(const Unit&) const {}
    __device__ __forceinline__ void done(const Unit&) const {}
};

__device__ __forceinline__ unsigned cvt_pk_bf16(float lo, float hi) { unsigned r; asm volatile("v_cvt_pk_bf16_f32 %0, %1, %2" : "=v"(r) : "v"(lo), "v"(hi)); return r; }
typedef float f32x2 __attribute__((ext_vector_type(2)));
__device__ __forceinline__ f32x2 gelu_pk(f32x2 v) {
    const f32x2 av = __builtin_elementwise_abs(v), d = av * 0.2316418882f + 1.0f;
    f32x2 t; t.x = __builtin_amdgcn_rcpf(d.x); t.y = __builtin_amdgcn_rcpf(d.y);
    f32x2 q = t * 0.5307027145f + (-0.7265760135f); q = q * t + 0.7107068705f; q = q * t + (-0.142248368f); q = q * t + 0.127414796f; q = q * t;
    const f32x2 s = (v * v) * (-0.72134752044f);
    f32x2 e; e.x = __builtin_amdgcn_exp2f(s.x); e.y = __builtin_amdgcn_exp2f(s.y);
    const f32x2 m = v * (q * e), r = v - m;
    f32x2 o; o.x = v.x < 0.f ? m.x : r.x; o.y = v.y < 0.f ? m.y : r.y; return o;
}

template <int ACT  > struct EpiBf16 {
    static constexpr bool PERM = true, AFTER_DRAIN = false; static_assert(ACT == 0 || ACT == 1, "EpiBf16: ACT is 0 (none) or 1 (gelu_pk)");
    bf16_t* O; int ldc; const float* bias; int split_cols; size_t split_stride; float scale0;
    __device__ __forceinline__ void operator()(const f32x4 (&acc)[2][2][4][2], const Unit& u, int wr, int wc, int fr, int fq) const {
        const int row0 = u.pm * BM + wr * 64 + fr; int colt = u.pn * BM; bf16_t* base = O;
        float sc = 1.f; if (split_cols) { const int t = colt / split_cols; base += (size_t)t * split_stride; colt -= t * split_cols; if (t == 0) sc = scale0; }
        const int col0 = colt + wc * 32 + 8 * fq, bcol0 = u.pn * BM + wc * 32 + 8 * fq;
        f32x4 bv[2][2];
#pragma unroll
        for (int bj = 0; bj < 2; ++bj)
#pragma unroll
            for (int n = 0; n < 2; ++n) bv[bj][n] = bias ? *(const f32x4*)(bias + bcol0 + bj * HALF + 4 * n) : (f32x4){0.f, 0.f, 0.f, 0.f};
#pragma unroll
        for (int ai = 0; ai < 2; ++ai)
#pragma unroll
            for (int m = 0; m < 4; ++m) { bf16_t* rowp = base + (size_t)(row0 + ai * HALF + m * 16) * ldc + col0;
#pragma unroll
                for (int bj = 0; bj < 2; ++bj) { f32x4 v0 = acc[ai][bj][m][0] + bv[bj][0], v1 = acc[ai][bj][m][1] + bv[bj][1];
                    if (ACT == 1) { f32x2 a = gelu_pk((f32x2){v0[0], v0[1]}), b = gelu_pk((f32x2){v0[2], v0[3]}), c = gelu_pk((f32x2){v1[0], v1[1]}), d = gelu_pk((f32x2){v1[2], v1[3]});
                        v0 = (f32x4){a.x, a.y, b.x, b.y}; v1 = (f32x4){c.x, c.y, d.x, d.y}; }
                    v0 = v0 * sc; v1 = v1 * sc; u32x4 w; w.x = cvt_pk_bf16(v0[0], v0[1]); w.y = cvt_pk_bf16(v0[2], v0[3]); w.z = cvt_pk_bf16(v1[0], v1[1]); w.w = cvt_pk_bf16(v1[2], v1[3]);
                    *(u32x4*)(rowp + bj * HALF) = w; } }
    }
};
__device__ __forceinline__ int tidx() { int t = (int)threadIdx.x; asm volatile("" : "+v"(t)); return t & 511; }
__device__ __forceinline__ float bf_lo(unsigned w) { return __uint_as_float(w << 16); }
__device__ __forceinline__ float bf_hi(unsigned w) { return __uint_as_float(w & 0xffff0000u); }
__device__ __forceinline__ float sigm(float x) { return __builtin_amdgcn_rcpf(1.0f + __builtin_amdgcn_exp2f(-1.4426950408889634f * x)); }
__device__ __forceinline__ void unpack8(const u32x4 w, float (&f)[8]) { f[0] = bf_lo(w.x); f[1] = bf_hi(w.x); f[2] = bf_lo(w.y); f[3] = bf_hi(w.y); f[4] = bf_lo(w.z); f[5] = bf_hi(w.z); f[6] = bf_lo(w.w); f[7] = bf_hi(w.w); }
__device__ __forceinline__ u32x4 pack8f(const float (&o)[8]) { u32x4 w; w.x = cvt_pk_bf16(o[0], o[1]); w.y = cvt_pk_bf16(o[2], o[3]); w.z = cvt_pk_bf16(o[4], o[5]); w.w = cvt_pk_bf16(o[6], o[7]); return w; }
#define PG8_EPI_LOOP_BEGIN \
        const int row0 = u.pm * BM + wr * 64 + fr, col0 = u.pn * BM + wc * 32 + 8 * fq; \
        _Pragma("unroll") for (int ai = 0; ai < 2; ++ai) _Pragma("unroll") for (int m = 0; m < 4; ++m) { const size_t row = (size_t)(row0 + ai * HALF + m * 16); \
            _Pragma("unroll") for (int bj = 0; bj < 2; ++bj) { const int col = col0 + bj * HALF; const f32x4 v0 = acc[ai][bj][m][0], v1 = acc[ai][bj][m][1]; \
                const float a[8] = {v0[0], v0[1], v0[2], v0[3], v1[0], v1[1], v1[2], v1[3]};
#define PG8_EPI_LOOP_END } asm volatile("" ::: "memory"); }
struct EpiGlu {
    static constexpr bool PERM = true, AFTER_DRAIN = false;
    const bf16_t* G; const bf16_t* P; bf16_t* YS; int zcol;
    __device__ __forceinline__ void operator()(const f32x4 (&acc)[2][2][4][2], const Unit& u, int wr, int wc, int fr, int fq) const {
        PG8_EPI_LOOP_BEGIN
                float g[8], z[8], o[8]; unpack8(*(const u32x4*)(G + row * 2048 + col), g); unpack8(*(const u32x4*)(P + row * 20480 + zcol + col), z);
#pragma unroll
                for (int e = 0; e < 8; ++e) o[e] = g[e] * sigm(a[e]) * (z[e] * sigm(z[e]));
                *(u32x4*)(YS + row * 2048 + col) = pack8f(o);
        PG8_EPI_LOOP_END
    }
};
struct EpiPs {
    static constexpr bool PERM = true, AFTER_DRAIN = false;
    const bf16_t* P; bf16_t* T; int gcol;
    __device__ __forceinline__ void operator()(const f32x4 (&acc)[2][2][4][2], const Unit& u, int wr, int wc, int fr, int fq) const {
        PG8_EPI_LOOP_BEGIN
                float g[8], o[8]; unpack8(*(const u32x4*)(P + row * 20480 + gcol + col), g);
#pragma unroll
                for (int e = 0; e < 8; ++e) o[e] = sigm(g[e]) * a[e];
                *(u32x4*)(T + row * 4096 + col) = pack8f(o);
        PG8_EPI_LOOP_END
    }
};
struct EpiPa {
    static constexpr bool PERM = true, AFTER_DRAIN = false;
    const bf16_t* P; const bf16_t* T; bf16_t* MG; int gcol;
    __device__ __forceinline__ void operator()(const f32x4 (&acc)[2][2][4][2], const Unit& u, int wr, int wc, int fr, int fq) const {
        PG8_EPI_LOOP_BEGIN
                float g[8], t[8], o[8]; unpack8(*(const u32x4*)(P + row * 20480 + gcol + col), g); unpack8(*(const u32x4*)(T + row * 4096 + col), t);
#pragma unroll
                for (int e = 0; e < 8; ++e) o[e] = t[e] + sigm(g[e]) * a[e];
                *(u32x4*)(MG + row * 4096 + col) = pack8f(o);
        PG8_EPI_LOOP_END
    }
};
struct EpiRes {
    static constexpr bool PERM = true, AFTER_DRAIN = false;
    const float* R; float* O; const float* gate;
    __device__ __forceinline__ void operator()(const f32x4 (&acc)[2][2][4][2], const Unit& u, int wr, int wc, int fr, int fq) const {
        const float* gt = gate + (size_t)(u.pm >> 4) * 12288;
        PG8_EPI_LOOP_BEGIN
                const f32x4 r0 = *(const f32x4*)(R + row * 4096 + col), r1 = *(const f32x4*)(R + row * 4096 + col + 4);
                const f32x4 g0 = *(const f32x4*)(gt + col), g1 = *(const f32x4*)(gt + col + 4);
                *(f32x4*)(O + row * 4096 + col) = r0 + g0 * v0; *(f32x4*)(O + row * 4096 + col + 4) = r1 + g1 * v1; (void)a;
        PG8_EPI_LOOP_END
    }
};
template <class Epi, class Sched, bool ALIGN_EPI = false, bool SP2 = false>
__device__ __forceinline__ void gemm_phase(PG8_LAS unsigned char* lds, const Gemm g, const Sched& S, const Epi& E) {
    const int tid = pg8::tidx(), wid = __builtin_amdgcn_readfirstlane(tid >> 6), lane = tid & 63, wr = wid >> 2, wc = wid & 3, fr = lane & 15, fq = lane >> 4;
    const int K = g.K, nt = K / BK;
    unsigned voffA[2], voffB[2];
#pragma unroll
    for (int i = 0; i < 2; ++i) { int R, C; stage_rc(tid * 16 + i * 8192, R, C); const int Rb = Epi::PERM ? ((R & ~31) + perm32(R & 31)) : R;
        voffA[i] = (unsigned)(R * K + C) * 2u; voffB[i] = (unsigned)(Rb * K + C) * 2u; }
    const size_t kstep = (size_t)(BK * 2);
    const size_t hstep = (size_t)HALF * K * 2;
    const size_t tstep = 2 * hstep;
    const unsigned ldsw = (unsigned)wid * 1024u;
    const int aoff = lds_byte(wr * 64 + fr, fq * 8), boff = lds_byte(wc * 32 + fr, fq * 8);
#define PG8_SA(b, h) (((b) * 2 + (h)) * HTB)
#define PG8_SB(b, h) ((4 + (b) * 2 + (h)) * HTB)
#define PG8_STAGE(bufoff, gbase, voff) do { _Pragma("unroll") for (int _i = 0; _i < 2; ++_i) \
        __builtin_amdgcn_global_load_lds((const unsigned*)((const char*)(gbase) + (voff)[_i]), (PG8_LAS unsigned*)(lds + (bufoff) + ldsw + _i * 8192), 16, 0, 0); } while (0)
#define PG8_LDA(dst, b, h) do { _Pragma("unroll") for (int m = 0; m < 4; ++m) _Pragma("unroll") for (int k = 0; k < 2; ++k) dst[m][k] = *(const PG8_LAS bf16x8*)(lds + PG8_SA(b, h) + aoff + m * 2048 + k * 1024); } while (0)
#define PG8_LDB(dst, b, h) do { _Pragma("unroll") for (int n = 0; n < 2; ++n) _Pragma("unroll") for (int k = 0; k < 2; ++k) dst[n][k] = *(const PG8_LAS bf16x8*)(lds + PG8_SB(b, h) + boff + n * 2048 + k * 1024); } while (0)
#define PG8_MMA(ai, bj, At, Bt) do { __builtin_amdgcn_s_setprio(1); _Pragma("unroll") for (int m = 0; m < 4; ++m) _Pragma("unroll") for (int n = 0; n < 2; ++n) _Pragma("unroll") for (int k = 0; k < 2; ++k) \
        acc[ai][bj][m][n] = __builtin_amdgcn_mfma_f32_16x16x32_bf16(Bt[n][k], At[m][k], acc[ai][bj][m][n], 0, 0, 0); __builtin_amdgcn_s_setprio(0); } while (0)
#define PG8_WAIT_V(n) asm volatile("s_waitcnt vmcnt(" #n ")" ::: "memory")
#define PG8_WAIT_L(n) asm volatile("s_waitcnt lgkmcnt(" #n ")" ::: "memory")
#define PG8_BAR __builtin_amdgcn_s_barrier()
#define PG8_SCHED __builtin_amdgcn_sched_barrier(0)
    Unit cur, nxt; int ui = 0;
    if (!S.next(0, cur)) return;
    f32x4 acc[2][2][4][2];
#pragma unroll
    for (int a = 0; a < 2; ++a)
#pragma unroll
        for (int b = 0; b < 2; ++b)
#pragma unroll
            for (int m = 0; m < 4; ++m)
#pragma unroll
                for (int n = 0; n < 2; ++n) acc[a][b][m][n] = (f32x4){0.f, 0.f, 0.f, 0.f};
    bf16x8 At[4][2], B0[2][2], B1[2][2];
    const char* cA = (const char*)g.A + (size_t)cur.pm * tstep; const char* cB = (const char*)g.Bt + (size_t)cur.pn * tstep;
    S.a_ready(cur);
    if constexpr (SP2) {
        PG8_STAGE(PG8_SB(0, 0), cB, voffB); PG8_STAGE(PG8_SB(0, 1), cB + hstep, voffB); PG8_STAGE(PG8_SA(0, 0), cA, voffA); PG8_STAGE(PG8_SA(0, 1), cA + hstep, voffA);
        if (wr == 1) PG8_BAR;
        PG8_WAIT_V(2); PG8_BAR;
        PG8_STAGE(PG8_SB(1, 0), cB + kstep, voffB); PG8_STAGE(PG8_SA(1, 0), cA + kstep, voffA); PG8_STAGE(PG8_SB(1, 1), cB + hstep + kstep, voffB);
        PG8_WAIT_V(6); PG8_BAR;
    } else {
        PG8_STAGE(PG8_SB(0, 0), cB, voffB); PG8_STAGE(PG8_SA(0, 0), cA, voffA); PG8_STAGE(PG8_SB(0, 1), cB + hstep, voffB); PG8_STAGE(PG8_SA(0, 1), cA + hstep, voffA);
        if (wr == 1) PG8_BAR;
        PG8_WAIT_V(4); PG8_BAR;
        PG8_STAGE(PG8_SB(1, 0), cB + kstep, voffB); PG8_STAGE(PG8_SA(1, 0), cA + kstep, voffA); PG8_STAGE(PG8_SB(1, 1), cB + hstep + kstep, voffB);
        PG8_WAIT_V(6); PG8_BAR;
    }
    for (;;) {
        const bool has_next = S.next(ui + 1, nxt);
        const char* nA = has_next ? (const char*)g.A + (size_t)nxt.pm * tstep : cA; const char* nB = has_next ? (const char*)g.Bt + (size_t)nxt.pn * tstep : cB;
        for (int t = 0; t < nt; t += 2) {
            const bool last = (t == nt - 2);
            const char* a1 = cA + (size_t)(t + 1) * kstep;
            const char* a2 = last ? nA : cA + (size_t)(t + 2) * kstep; const char* b2 = last ? nB : cB + (size_t)(t + 2) * kstep;
            const char* a3 = a2 + kstep; const char* b3 = b2 + kstep;
            if (last && has_next) S.a_ready(nxt);
            if constexpr (SP2) {
            PG8_LDB(B0, 0, 0); PG8_LDB(B1, 0, 1); PG8_SCHED; PG8_LDA(At, 0, 0); PG8_STAGE(PG8_SA(1, 1), a1 + hstep, voffA);
            PG8_WAIT_V(8); PG8_WAIT_L(0); PG8_BAR; PG8_MMA(0, 0, At, B0); PG8_MMA(0, 1, At, B1); PG8_BAR; PG8_SCHED;
            PG8_LDA(At, 0, 1); PG8_STAGE(PG8_SB(0, 0), b2, voffB); PG8_STAGE(PG8_SB(0, 1), b2 + hstep, voffB); PG8_STAGE(PG8_SA(0, 0), a2, voffA);
            PG8_WAIT_V(8); PG8_WAIT_L(0); PG8_BAR; PG8_MMA(1, 0, At, B0); PG8_MMA(1, 1, At, B1); PG8_BAR; PG8_SCHED;
            PG8_LDB(B0, 1, 0); PG8_LDB(B1, 1, 1); PG8_SCHED; PG8_LDA(At, 1, 0); PG8_STAGE(PG8_SA(0, 1), a2 + hstep, voffA);
            PG8_WAIT_V(8); PG8_WAIT_L(0); PG8_BAR; PG8_MMA(0, 0, At, B0); PG8_MMA(0, 1, At, B1); PG8_BAR; PG8_SCHED;
            PG8_LDA(At, 1, 1); PG8_STAGE(PG8_SB(1, 0), b3, voffB); PG8_STAGE(PG8_SB(1, 1), b3 + hstep, voffB); PG8_STAGE(PG8_SA(1, 0), a3, voffA);
            PG8_WAIT_V(8); PG8_WAIT_L(0); PG8_BAR; PG8_MMA(1, 0, At, B0); PG8_MMA(1, 1, At, B1); PG8_BAR; PG8_SCHED;
            } else {
            PG8_LDB(B0, 0, 0); PG8_SCHED; PG8_LDA(At, 0, 0); PG8_STAGE(PG8_SA(1, 1), a1 + hstep, voffA);
            PG8_WAIT_L(8); PG8_BAR; PG8_WAIT_L(0); PG8_MMA(0, 0, At, B0); PG8_BAR; PG8_SCHED;
            PG8_LDB(B1, 0, 1); PG8_STAGE(PG8_SB(0, 0), b2, voffB);
            PG8_BAR; PG8_WAIT_L(0); PG8_MMA(0, 1, At, B1); PG8_BAR;
            PG8_LDA(At, 0, 1); PG8_STAGE(PG8_SA(0, 0), a2, voffA);
            PG8_BAR; PG8_WAIT_L(0); PG8_MMA(1, 0, At, B0); PG8_BAR; PG8_SCHED;
            PG8_STAGE(PG8_SB(0, 1), b2 + hstep, voffB);
            PG8_WAIT_V(6); PG8_BAR; PG8_MMA(1, 1, At, B1); PG8_BAR;
            PG8_LDB(B0, 1, 0); PG8_SCHED; PG8_LDA(At, 1, 0); PG8_STAGE(PG8_SA(0, 1), a2 + hstep, voffA);
            PG8_WAIT_L(8); PG8_BAR; PG8_WAIT_L(0); PG8_MMA(0, 0, At, B0); PG8_BAR; PG8_SCHED;
            PG8_LDB(B1, 1, 1); PG8_STAGE(PG8_SB(1, 0), b3, voffB);
            PG8_BAR; PG8_WAIT_L(0); PG8_MMA(0, 1, At, B1); PG8_BAR;
            PG8_LDA(At, 1, 1); PG8_STAGE(PG8_SA(1, 0), a3, voffA);
            PG8_BAR; PG8_WAIT_L(0); PG8_MMA(1, 0, At, B0); PG8_BAR; PG8_SCHED;
            PG8_STAGE(PG8_SB(1, 1), b3 + hstep, voffB);
            PG8_WAIT_V(6); PG8_BAR; PG8_MMA(1, 1, At, B1); PG8_BAR;
            }
        }
        if constexpr (ALIGN_EPI) { if (wr == 0) PG8_BAR; }
        if constexpr (!Epi::AFTER_DRAIN) { E(acc, cur, wr, wc, fr, fq); S.done(cur); }
        if (!has_next) break;
#pragma unroll
        for (int a = 0; a < 2; ++a)
#pragma unroll
            for (int b = 0; b < 2; ++b)
#pragma unroll
                for (int m = 0; m < 4; ++m)
#pragma unroll
                    for (int n = 0; n < 2; ++n) acc[a][b][m][n] = (f32x4){0.f, 0.f, 0.f, 0.f};
        cur = nxt; cA = nA; cB = nB; ++ui;
        if constexpr (ALIGN_EPI) { if (wr == 1) PG8_BAR; }
    }
    PG8_WAIT_V(0);
    if constexpr (!ALIGN_EPI) { if (wr == 0) PG8_BAR; }
    PG8_BAR;
    if constexpr (Epi::AFTER_DRAIN) { E.fused(acc, cur, wr, wc, fr, fq, lds, wid, lane); S.done(cur); }
#undef PG8_SA
#undef PG8_SB
#undef PG8_STAGE
#undef PG8_LDA
#undef PG8_LDB
#undef PG8_MMA
#undef PG8_WAIT_V
#undef PG8_WAIT_L
#undef PG8_BAR
#undef PG8_SCHED
}
}
namespace att {
typedef unsigned short bf16;
typedef short bf16x8 __attribute__((ext_vector_type(8)));
typedef short s16x4 __attribute__((ext_vector_type(4)));
typedef float f32x16 __attribute__((ext_vector_type(16)));
typedef float f32x4 __attribute__((ext_vector_type(4)));
typedef unsigned u32x4 __attribute__((ext_vector_type(4)));
constexpr int D = 128, PITCH = 20480, OPITCH = 2048, SKV = 4096;
constexpr float THR = 8.f;
constexpr float SCALE = 0.08838834764831845f;
constexpr int NW = 8, QBLK = 32, KVBLK = 64, QB = NW * QBLK;
constexpr int SHM_V = KVBLK * D * 2, SHM_K = KVBLK * D * 2;
constexpr int LDS_WS = 2 * SHM_V + 2 * SHM_K, LDS_LUT = LDS_WS + NW * 64 * 4, LUT_STRIDE = 132  , LUTX = 480, LUTX_ZERO = 256  , LDS_BYTES = LDS_LUT + 8 * LUTX * 4;

#define KSWZ(row, colB) ((row) * 256 + ((colB) ^ (((row) & 7) << 4)))
#define SBAR() __builtin_amdgcn_sched_barrier(0)
__device__ __forceinline__ int v_st(int k, int c) { const int kk = (k & ~0xC) | ((k & 4) << 1) | ((k & 8) >> 1); return ((kk >> 3) * 4 + (c >> 5)) * 512 + ((kk & 7) * 32 + (c & 31)) * 2; }
__device__ __forceinline__ int v_rd_base(int lane) { return ((lane & 3) << 3) | (((lane >> 2) & 3) << 6) | (((lane >> 4) & 1) << 5) | (((lane >> 5) & 1) << 8); }
constexpr int v_rd_off(int d0, int ks, int half) { return d0 * 512 + ks * 4096 + half * 2048; }
__device__ __forceinline__ int crow(int r, int hi) { return (r & 3) + 8 * (r >> 2) + 4 * hi; }
__device__ __forceinline__ unsigned cvtpk(float lo, float hi) { unsigned r; asm volatile("v_cvt_pk_bf16_f32 %0, %1, %2" : "=v"(r) : "v"(lo), "v"(hi)); return r; }
__device__ __forceinline__ bf16x8 load8(const bf16* p) { return *reinterpret_cast<const bf16x8*>(p); }
__device__ __forceinline__ __amdgpu_buffer_rsrc_t mkrsrc(const void* p) { return __builtin_amdgcn_make_buffer_rsrc((void*)p, 0, 0x7fffffff, 0x00020000); }
__device__ __forceinline__ bf16x8 bload(__amdgpu_buffer_rsrc_t r, unsigned voff, unsigned soff) { return __builtin_bit_cast(bf16x8, __builtin_amdgcn_raw_buffer_load_b128(r, voff, soff, 0)); }
__device__ __forceinline__ void mask_bias_tile(f32x16& p0, f32x16& p1, const float* lp) {
#pragma unroll
    for (int r = 0; r < 16; ++r) {
        const int c = (r & 3) + 8 * (r >> 2);
        p0[r] += lp[59 - c];
        p1[r] += lp[59 - c - 32];
    }
}
__device__ __forceinline__ void partialSM(f32x16& p0, f32x16& p1, float& m_reg, float& mn, float& alpha) {
    float pmax = p0[0]; for (int r = 1; r < 16; ++r) pmax = fmaxf(pmax, p0[r]); for (int r = 0; r < 16; ++r) pmax = fmaxf(pmax, p1[r]);
    { auto rr = __builtin_amdgcn_permlane32_swap(__float_as_uint(pmax), __float_as_uint(pmax), false, false);
      pmax = fmaxf(__uint_as_float(rr[0]), __uint_as_float(rr[1])); }
    constexpr float C2 = 1.4426950408889634f * SCALE;
    if (__builtin_expect(__all((pmax - m_reg) * SCALE <= THR), 1)) { mn = m_reg; alpha = 1.f; }
    else { mn = fmaxf(m_reg, pmax); alpha = __builtin_amdgcn_exp2f((m_reg - mn) * C2); m_reg = mn; }
    const float mnL = -mn * C2;
    for (int r = 0; r < 16; ++r) p0[r] = fmaf(p0[r], C2, mnL); for (int r = 0; r < 16; ++r) p1[r] = fmaf(p1[r], C2, mnL);
    for (int r = 0; r < 16; ++r) p0[r] = __builtin_amdgcn_exp2f(p0[r]);
}
__device__ __forceinline__ void finishSM(f32x16& p0, f32x16& p1, float alpha, float& l_reg, bf16x8& pa0, bf16x8& pa1, bf16x8& pa2, bf16x8& pa3) {
    for (int r = 0; r < 16; ++r) p1[r] = __builtin_amdgcn_exp2f(p1[r]);
    float ps = 0; for (int r = 0; r < 16; ++r) ps += p0[r]; for (int r = 0; r < 16; ++r) ps += p1[r];
    { auto rr = __builtin_amdgcn_permlane32_swap(__float_as_uint(ps), __float_as_uint(ps), false, false);
      ps = __uint_as_float(rr[0]) + __uint_as_float(rr[1]); }
    l_reg = l_reg * alpha + ps;
#define PK4(P, B_, OUT) do { unsigned a0 = cvtpk(P[B_+0], P[B_+1]), a1 = cvtpk(P[B_+2], P[B_+3]);                          \
        unsigned b0 = cvtpk(P[B_+4], P[B_+5]), b1 = cvtpk(P[B_+6], P[B_+7]);                                             \
        auto r0 = __builtin_amdgcn_permlane32_swap(a0, b0, false, false); auto r1 = __builtin_amdgcn_permlane32_swap(a1, b1, false, false); \
        u32x4 w = {r0[0], r1[0], r0[1], r1[1]}; OUT = *reinterpret_cast<bf16x8*>(&w); } while (0)
    PK4(p0, 0, pa0); PK4(p0, 8, pa1); PK4(p1, 0, pa2); PK4(p1, 8, pa3);
#undef PK4
}
template <int KB>
__device__ __forceinline__ void qkt(f32x16& p0, f32x16& p1, const char* K_lds, int r32, int hi, const bf16x8* qr) {
    p0 = f32x16{}; p1 = f32x16{};
    const char* kb[4];
#pragma unroll
    for (int dd = 0; dd < 4; ++dd) kb[dd] = K_lds + KB * SHM_K + KSWZ(r32, (dd * 16 + hi * 8) * 2);
#pragma unroll
    for (int d0 = 0; d0 < 8; ++d0) { const char* a = kb[d0 & 3] + (d0 >> 2) * 128;
        bf16x8 b0 = *reinterpret_cast<const bf16x8*>(a);
        bf16x8 b1 = *reinterpret_cast<const bf16x8*>(a + 32 * 256);
        p0 = __builtin_amdgcn_mfma_f32_32x32x16_bf16(b0, qr[d0], p0, 0, 0, 0);
        p1 = __builtin_amdgcn_mfma_f32_32x32x16_bf16(b1, qr[d0], p1, 0, 0, 0); }
}
template <int VB>
__device__ __forceinline__ void pv_tile(f32x16* o, int vb0, bf16x8 pa0, bf16x8 pa1, bf16x8 pa2, bf16x8 pa3) {
#define TRRD(dst, off) asm volatile("ds_read_b64_tr_b16 %0, %1 offset:%2" : "=&v"(dst) : "v"(vb0), "i"(off) : "memory")
#define PV_D0(d0) do { s16x4 l0, l1, l2, l3, h0, h1, h2, h3; constexpr int b_ = VB * SHM_V + v_rd_off(d0, 0, 0);   \
        TRRD(l0, b_); TRRD(h0, b_ + 2048); TRRD(l1, b_ + 4096); TRRD(h1, b_ + 6144); TRRD(l2, b_ + 8192); TRRD(h2, b_ + 10240); TRRD(l3, b_ + 12288); TRRD(h3, b_ + 14336); \
        asm volatile("s_waitcnt lgkmcnt(0)" ::: "memory"); SBAR();                                                   \
        o[d0] = __builtin_amdgcn_mfma_f32_32x32x16_bf16(pa0, (bf16x8){l0[0], l0[1], l0[2], l0[3], h0[0], h0[1], h0[2], h0[3]}, o[d0], 0, 0, 0);   \
        o[d0] = __builtin_amdgcn_mfma_f32_32x32x16_bf16(pa1, (bf16x8){l1[0], l1[1], l1[2], l1[3], h1[0], h1[1], h1[2], h1[3]}, o[d0], 0, 0, 0);   \
        o[d0] = __builtin_amdgcn_mfma_f32_32x32x16_bf16(pa2, (bf16x8){l2[0], l2[1], l2[2], l2[3], h2[0], h2[1], h2[2], h2[3]}, o[d0], 0, 0, 0);   \
        o[d0] = __builtin_amdgcn_mfma_f32_32x32x16_bf16(pa3, (bf16x8){l3[0], l3[1], l3[2], l3[3], h3[0], h3[1], h3[2], h3[3]}, o[d0], 0, 0, 0); } while (0)
    PV_D0(0); PV_D0(1); PV_D0(2); PV_D0(3);
#undef PV_D0
#undef TRRD
}

struct BlockRef { const bf16* Q; const bf16* K; const bf16* V; float* O; int P0; int lut_off; };
struct Seam { bf16x8 qr[8]; bf16x8 st_v0, st_v1, st_k0, st_k1; };
#define VMW() asm volatile("s_waitcnt vmcnt(0)" ::: "memory")
#define VMWN(n) asm volatile("s_waitcnt vmcnt(%0)" :: "i"(n) : "memory")
#define SLOAD_H(rK_, rV_, k0) do { const unsigned so_ = (unsigned)(k0) * (unsigned)(PITCH * 2); S.st_v0 = bload(rV_, goff0, so_); S.st_v1 = bload(rV_, goff1, so_);              \
                         S.st_k0 = bload(rK_, goff0, so_); S.st_k1 = bload(rK_, goff1, so_); } while (0)
#define SWRITE_HK(bf) do { *(bf16x8*)(K_lds + (bf) * SHM_K + kws) = S.st_k0; *(bf16x8*)(K_lds + (bf) * SHM_K + kws + 32 * 256) = S.st_k1; } while (0)
#define SWRITE_HV(bf) do { *(bf16x8*)(V_lds + (bf) * SHM_V + vst0) = S.st_v0; *(bf16x8*)(V_lds + (bf) * SHM_V + vst1) = S.st_v1; } while (0)
#define SWRITE_H(bf) do { SWRITE_HV(bf); SWRITE_HK(bf); } while (0)
__device__ __forceinline__ void attn_prime(const BlockRef& cur, char* lds, Seam& S) {
    const int tid = pg8::tidx(), wid = __builtin_amdgcn_readfirstlane(tid >> 6), lane = tid & 63, r32 = lane & 31, hi = lane >> 5;
    const int sr = tid >> 4, sc = (tid & 15) * 8, kws = KSWZ(sr, sc * 2); char* K_lds = lds + 2 * SHM_V;
    const unsigned goff0 = (unsigned)(sr * PITCH + sc) * 2u, goff1 = goff0 + 32u * PITCH * 2u, qoff = (unsigned)((wid * QBLK + r32) * PITCH + hi * 8) * 2u;
    { const __amdgpu_buffer_rsrc_t rQ = mkrsrc(cur.Q), rK = mkrsrc(cur.K), rV = mkrsrc(cur.V);
      for (int d0 = 0; d0 < 8; ++d0) S.qr[d0] = bload(rQ, qoff + d0 * 32, 0);
      SLOAD_H(rK, rV, 0); } VMW(); SWRITE_HK(0);
    __syncthreads();
}
__device__ __forceinline__ void attn_block(const BlockRef& cur, const BlockRef& nxt, char* lds, Seam& S) {
    const int tid = pg8::tidx(), wid = __builtin_amdgcn_readfirstlane(tid >> 6), lane = tid & 63, r32 = lane & 31, hi = lane >> 5;
    const int NT = (cur.P0 + QB) / KVBLK;
    const int qlo = cur.P0 + wid * QBLK, qm = qlo + r32 - 4 * hi;
    char* V_lds = lds; char* K_lds = lds + 2 * SHM_V;
    float* ws = (float*)(lds + LDS_WS) + wid * 64; float* li_l = ws, * al_l = ws + 32;
    const float* lut = (const float*)(lds + cur.lut_off) + (LUTX_ZERO - 59) + qm;
    float m_reg = -1e30f, l_reg = 0; f32x16 o[4] = {};
    const int sr = tid >> 4, sc = (tid & 15) * 8, vst0 = v_st(sr, sc), vst1 = v_st(32 + sr, sc), kws = KSWZ(sr, sc * 2);
    const unsigned goff0 = (unsigned)(sr * PITCH + sc) * 2u, goff1 = goff0 + 32u * PITCH * 2u, qoff = (unsigned)((wid * QBLK + r32) * PITCH + hi * 8) * 2u;
    const int vb0 = (int)(uintptr_t)V_lds + v_rd_base(lane);
    const __amdgpu_buffer_rsrc_t Kh = mkrsrc(cur.K), Vh = mkrsrc(cur.V);
#define RESC(a) do { if (__any((a) < 1.f)) { if (hi == 0) al_l[r32] = (a); asm volatile("s_waitcnt lgkmcnt(0)" ::: "memory");              \
                     for (int d_ = 0; d_ < 4; ++d_) for (int r = 0; r < 16; ++r) o[d_][r] *= al_l[crow(r, hi)]; } } while (0)
#define KBASE(t) ((t) * KVBLK)
#define MASKT(P0_, P1_, t) do { const int kb_ = KBASE(t); if (kb_ + KVBLK - 1 + 128 > qlo) mask_bias_tile(P0_, P1_, lut - kb_); } while (0)
    constexpr int NQL = 8;
#define SEAM_K0() do { VMWN(NQL); SWRITE_HK(0); SBAR(); } while (0)
    f32x16 pA0, pA1, pB0, pB1; float mnA, mnB, alA, alB; bf16x8 pa0, pa1, pa2, pa3;
    SWRITE_HV(0); SBAR();
    if (NT > 1) { SLOAD_H(Kh, Vh, KBASE(1)); }
    SBAR(); qkt<0>(pA0, pA1, K_lds, r32, hi, S.qr);
    MASKT(pA0, pA1, 0); partialSM(pA0, pA1, m_reg, mnA, alA);
    if (NT > 1) { VMW(); SWRITE_H(1); }
    __syncthreads();
#define HALF_STEP(PX0, PX1, mnX, alX, PY0, PY1, alY, t, KB, VB, SB) do {                                                      \
        SBAR(); qkt<KB>(PX0, PX1, K_lds, r32, hi, S.qr);                                                         \
        finishSM(PY0, PY1, alY, l_reg, pa0, pa1, pa2, pa3); SBAR();                                                           \
        if ((t) + 1 < NT) { SLOAD_H(Kh, Vh, KBASE((t) + 1)); SBAR(); }                                               \
        pv_tile<VB>(o, vb0, pa0, pa1, pa2, pa3); MASKT(PX0, PX1, (t)); partialSM(PX0, PX1, m_reg, mnX, alX);                                        \
        __syncthreads();                                                                                                      \
        if ((t) + 1 < NT) { VMW(); SWRITE_H(SB); }                                                                          \
        RESC(alX); __syncthreads(); } while (0)
    for (int t = 1; t + 1 < NT; t += 2) {
        HALF_STEP(pB0, pB1, mnB, alB, pA0, pA1, alA, t, 1, 0, 0);
        HALF_STEP(pA0, pA1, mnA, alA, pB0, pB1, alB, t + 1, 0, 1, 1);
    }
    const bool even = (NT & 1) == 0;
    if (even) { SBAR(); qkt<1>(pB0, pB1, K_lds, r32, hi, S.qr); SBAR(); }
    { const __amdgpu_buffer_rsrc_t rQn = mkrsrc(nxt.Q), rKn = mkrsrc(nxt.K), rVn = mkrsrc(nxt.V);
      SLOAD_H(rKn, rVn, 0); SBAR();
#pragma unroll
      for (int d0 = 0; d0 < 8; ++d0) S.qr[d0] = bload(rQn, qoff + d0 * 32, 0); }
    SBAR();
    finishSM(pA0, pA1, alA, l_reg, pa0, pa1, pa2, pa3); SBAR();
    pv_tile<0>(o, vb0, pa0, pa1, pa2, pa3);
    if (even) { MASKT(pB0, pB1, NT - 1); partialSM(pB0, pB1, m_reg, mnB, alB); __syncthreads(); RESC(alB);
        finishSM(pB0, pB1, alB, l_reg, pa0, pa1, pa2, pa3); SBAR(); pv_tile<1>(o, vb0, pa0, pa1, pa2, pa3); }
    SBAR(); SEAM_K0();
    if (hi == 0) li_l[r32] = l_reg; asm volatile("s_waitcnt lgkmcnt(0)" ::: "memory");
    float rli[16];
#pragma unroll
    for (int r = 0; r < 16; ++r) rli[r] = __builtin_amdgcn_rcpf(li_l[crow(r, hi)]);
    char* Ow = (char*)(cur.O + (size_t)(wid * QBLK) * OPITCH); const unsigned ooff = (unsigned)(4 * hi * OPITCH + r32) * 4u;
#pragma unroll
    for (int r = 0; r < 16; ++r) { const int orow = (r & 3) + 8 * (r >> 2);
#pragma unroll
        for (int d0 = 0; d0 < 4; ++d0) { const float v = o[d0][r] * rli[r]; *(float*)(Ow + (size_t)(orow * OPITCH + d0 * 32) * 4 + ooff) = v; } }
    __syncthreads();
#undef RESC
#undef KBASE
#undef MASKT
#undef SEAM_K0
#undef HALF_STEP
}
#undef VMW
#undef VMWN
#undef SLOAD_H
#undef SWRITE_HK
#undef SWRITE_HV
#undef SWRITE_H
__device__ __forceinline__ bool attn_ref(int s, int vcu, int G, const bf16* proj, float* O4, int cq, int ck, int cv, BlockRef& r) {
    const int L = 2 * vcu + ((s >> 1) & 1) + (s >> 2) * 2 * G; if (L >= 512) return false;
    const int bhm = L >> 4, vh = (L >> 3) & 1, pair = L & 7, b = bhm >> 4, h = (bhm >> 1) & 7, m = bhm & 1, qb = (s & 1) ? 15 - pair : pair;
    const size_t rowb = (size_t)b * SKV;
    r.Q = proj + (rowb + (size_t)qb * QB) * PITCH + cq + h * 256 + m * 128;
    r.K = proj + rowb * PITCH + ck + h * 256 + m * 128;
    r.V = proj + rowb * PITCH + cv + h * 256 + vh * 128;
    r.O = O4 + ((size_t)m * 8192 + rowb + (size_t)qb * QB) * OPITCH + h * 256 + vh * 128;
    r.P0 = qb * QB; r.lut_off = LDS_LUT + h * LUTX * 4;
    return true;
}
__device__ __forceinline__ void attn_phase(char* lds, const bf16* proj, float* O4, const float* lutg, int vcu, int G, int cq, int ck, int cv) {
    for (int i = pg8::tidx(); i < 8 * LUTX; i += NW * 64) { const int hh = i / LUTX, d = i % LUTX - LUTX_ZERO;
        ((float*)(lds + LDS_LUT))[i] = d < 0 ? -__builtin_inff() : (d < 128 ? lutg[hh * LUT_STRIDE + d] : 0.f); }
    __syncthreads();
    BlockRef cur, nxt; int s = 0;
    if (!attn_ref(0, vcu, G, proj, O4, cq, ck, cv, cur)) return;
    Seam S;
    attn_prime(cur, lds, S);
    for (;;) {
        const bool more = attn_ref(s + 1, vcu, G, proj, O4, cq, ck, cv, nxt);
        if (!more) nxt = cur;
        attn_block(cur, nxt, lds, S);
        if (!more) break;
        cur = nxt; ++s;
    }
}
#undef KSWZ
#undef SBAR
}
namespace s5 {
typedef unsigned short bf16;
typedef short bf16x8 __attribute__((ext_vector_type(8)));
typedef short s16x4 __attribute__((ext_vector_type(4)));
typedef float f32x16 __attribute__((ext_vector_type(16)));
typedef float f32x4 __attribute__((ext_vector_type(4)));
typedef unsigned u32x2 __attribute__((ext_vector_type(2)));
constexpr int P_AB = 0, P_BF = 1024, P_CF = P_BF + 4096, P_DF = P_CF + 8192, P_BYTES = P_DF + 2048;
constexpr int IMG_ROW = 72, IMG_TILE = 32 * IMG_ROW, IMG_WAVE = 4 * IMG_TILE;
constexpr int LDS_E = 8 * IMG_WAVE, LDS_BYTES = LDS_E + 16 * 32 * 16;
constexpr int PITCH = 20480, GP = 2048;
__device__ __forceinline__ unsigned cvtpk(float lo, float hi) { unsigned r; asm volatile("v_cvt_pk_bf16_f32 %0, %1, %2" : "=v"(r) : "v"(lo), "v"(hi)); return r; }
__device__ __forceinline__ unsigned f2bf(float f) { unsigned u = __builtin_bit_cast(unsigned, f); return (u + 0x7fffu + ((u >> 16) & 1u)) >> 16; }
#define S5_MFMA(a, b, c) __builtin_amdgcn_mfma_f32_32x32x16_bf16((a), (b), (c), 0, 0, 0)
#define S5_SCAN16(STORE) _Pragma("unroll") for (int r = 0; r < 16; ++r) { \
        const float n0r = fmaf(a0r, h0r, fmaf(-a0i, h0i, x0[r])), n0i = fmaf(a0r, h0i, fmaf(a0i, h0r, x2[r])); \
        const float n1r = fmaf(a1r, h1r, fmaf(-a1i, h1i, x1[r])), n1i = fmaf(a1r, h1i, fmaf(a1i, h1r, x3[r])); \
        h0r = n0r; h0i = n0i; h1r = n1r; h1i = n1i; if (STORE) { x0[r] = n0r; x2[r] = n0i; x1[r] = n1r; x3[r] = n1i; } }
__device__ __forceinline__ void s5_unit(char* lds, const bf16* proj, bf16* Gout, const char* prm, int b, int g) {
    const int tid = pg8::tidx(), wid = __builtin_amdgcn_readfirstlane(tid >> 6), lane = tid & 63, j = lane & 31, h = lane >> 5;
    const f32x4 ab = *(const f32x4*)(prm + P_AB + j * 32), ap = *(const f32x4*)(prm + P_AB + j * 32 + 16);
    const float a0r = ab[0], a0i = ab[1], a1r = ab[2], a1i = ab[3];
    bf16x8 Bf[4];
#pragma unroll
    for (int n = 0; n < 4; ++n) Bf[n] = *(const bf16x8*)(prm + P_BF + (n * 64 + lane) * 16);
    const int tok0 = 512 * wid + 256 * ((j >> 2) & 1) + (j & 3) + 4 * (j >> 3);
    const bf16* up = proj + ((size_t)b * 4096 + tok0) * PITCH + g * 16 + 8 * h;
    const f32x16 zero = {};
    f32x4* E = (f32x4*)(lds + LDS_E);
    float h0r = 0.f, h0i = 0.f, h1r = 0.f, h1i = 0.f;
    {
        bf16x8 uf = *(const bf16x8*)up;
        for (int k = 0; k < 16; ++k) {
            const bf16x8 ufn = *(const bf16x8*)(up + (size_t)((k < 15 ? k + 1 : k) * 16) * PITCH);
            f32x16 x0 = S5_MFMA(uf, Bf[0], zero), x1 = S5_MFMA(uf, Bf[1], zero), x2 = S5_MFMA(uf, Bf[2], zero), x3 = S5_MFMA(uf, Bf[3], zero);
            S5_SCAN16(false)
            uf = ufn;
        }
    }
    E[(2 * wid + h) * 32 + j] = (f32x4){h0r, h0i, h1r, h1i};
    __syncthreads();
    h0r = 0.f; h0i = 0.f; h1r = 0.f; h1i = 0.f;
    {
        const int chunk = 2 * wid + h;
        for (int c = 0; c < 2 * wid + 1; ++c) {
            const f32x4 e = E[c * 32 + j];
            const float n0r = fmaf(ap[0], h0r, fmaf(-ap[1], h0i, e[0])), n0i = fmaf(ap[0], h0i, fmaf(ap[1], h0r, e[1]));
            const float n1r = fmaf(ap[2], h1r, fmaf(-ap[3], h1i, e[2])), n1i = fmaf(ap[2], h1i, fmaf(ap[3], h1r, e[3]));
            if (c < chunk) { h0r = n0r; h0i = n0i; h1r = n1r; h1i = n1i; }
        }
    }
    bf16x8 Cf[4][2], Df[2];
#pragma unroll
    for (int n = 0; n < 4; ++n)
#pragma unroll
        for (int s = 0; s < 2; ++s) Cf[n][s] = *(const bf16x8*)(prm + P_CF + ((n * 2 + s) * 64 + lane) * 16);
    Df[0] = *(const bf16x8*)(prm + P_DF + lane * 16); Df[1] = *(const bf16x8*)(prm + P_DF + (64 + lane) * 16);
    char* img = lds + wid * IMG_WAVE;
    char* stp = img + j * IMG_ROW + 8 * h;
    const int i16 = lane & 15, q = i16 >> 2, p = i16 & 3, blk = (lane >> 4) & 1;
    const unsigned trb = (unsigned)(uintptr_t)img + (8 * h + q) * IMG_ROW + 8 * (4 * blk + p);
    bf16* gp = Gout + ((size_t)b * 4096 + 512 * wid + 256 * h) * GP + g * 16 + j;
    {
        bf16x8 uf = *(const bf16x8*)up;
        for (int k = 0; k < 16; ++k) {
            const bf16x8 ufn = *(const bf16x8*)(up + (size_t)((k < 15 ? k + 1 : k) * 16) * PITCH);
            f32x16 x0 = S5_MFMA(uf, Bf[0], zero), x1 = S5_MFMA(uf, Bf[1], zero), x2 = S5_MFMA(uf, Bf[2], zero), x3 = S5_MFMA(uf, Bf[3], zero);
            S5_SCAN16(true)
#define S5_IMG(X, n) _Pragma("unroll") for (int g4 = 0; g4 < 4; ++g4) { u32x2 w; w.x = cvtpk(X[4 * g4], X[4 * g4 + 1]); w.y = cvtpk(X[4 * g4 + 2], X[4 * g4 + 3]); *(u32x2*)(stp + (n) * IMG_TILE + 16 * g4) = w; }
            S5_IMG(x0, 0) S5_IMG(x1, 1) S5_IMG(x2, 2) S5_IMG(x3, 3)
#undef S5_IMG
            asm volatile("s_waitcnt lgkmcnt(0)" ::: "memory"); __builtin_amdgcn_sched_barrier(0);
            f32x16 y = zero;
#define S5_TR(dst, off) asm volatile("ds_read_b64_tr_b16 %0, %1 offset:%2" : "=&v"(dst) : "v"(trb), "i"(off) : "memory")
#define S5_YN(n) do { s16x4 l0, q0, l1, q1; S5_TR(l0, (n) * IMG_TILE); S5_TR(q0, (n) * IMG_TILE + 4 * IMG_ROW); S5_TR(l1, (n) * IMG_TILE + 16 * IMG_ROW); S5_TR(q1, (n) * IMG_TILE + 20 * IMG_ROW); \
            asm volatile("s_waitcnt lgkmcnt(0)" ::: "memory"); __builtin_amdgcn_sched_barrier(0); \
            y = S5_MFMA(((bf16x8){l0[0], l0[1], l0[2], l0[3], q0[0], q0[1], q0[2], q0[3]}), Cf[n][0], y); \
            y = S5_MFMA(((bf16x8){l1[0], l1[1], l1[2], l1[3], q1[0], q1[1], q1[2], q1[3]}), Cf[n][1], y); } while (0)
            S5_YN(0); S5_YN(1); S5_YN(2); S5_YN(3);
#undef S5_YN
#undef S5_TR
            y = S5_MFMA(uf, Df[0], y); y = S5_MFMA(uf, Df[1], y);
#pragma unroll
            for (int i = 0; i < 16; ++i) {
                const float v = y[i], t = 1.5957691216057308f * (v + 0.044715f * v * v * v);
                const float gl = v * __builtin_amdgcn_rcpf(1.0f + __builtin_amdgcn_exp2f(-1.4426950408889634f * t));
                if (j < 16) gp[(size_t)(16 * k + i) * GP] = (bf16)f2bf(gl);
            }
            uf = ufn;
        }
    }
    __syncthreads();
}
#undef S5_MFMA
#undef S5_SCAN16
}
constexpr int NWAVES = 8;
#ifndef MK_SPLIT
#define MK_SPLIT 0
#endif
constexpr int N_PHASES = 15;

constexpr int BATCH = 2, SEQ = 4096, DM = 4096, M = BATCH * SEQ, DSSM = 2048, DATT = 2048, NIN = 20480, NHEAD = 8, NGRP = 128, DEPTH = 2;
constexpr int C_US = 0, C_ZS = 2048, C_Q = 4096, C_K = 6144, C_V = 8192, C_ZA = 10240, C_GS = 12288, C_GA = 16384;
constexpr float EPS = 1e-6f, SUBLN_EPS = 1e-5f;
enum { I_X = 0, I_C, I_NORMG, I_WADA, I_BADA, I_WIN, I_LRE, I_LIM, I_LDT, I_BRE, I_BIM, I_CRE, I_CIM, I_SD, I_WGLU, I_LQ1, I_LK1, I_LQ2, I_LK2, I_SUBG, I_WOS, I_WOA, I_WO, I_RELB, I_FING, N_INPUTS };

constexpr size_t MiB = 1u << 20;
constexpr size_t WS_CTL = 0, CTL_ZERO_BYTES = 1 * MiB;
constexpr size_t WS_MODP = 1 * MiB;
constexpr size_t WS_MOD = 4 * MiB;
constexpr size_t WS_LUT = 4 * MiB + 256 * 1024;
constexpr size_t WS_S5P = 5 * MiB;
constexpr size_t WS_WT = 16 * MiB;
constexpr size_t WT_IN = 0, WT_GLU = 160 * MiB, WT_OS = 168 * MiB, WT_OA = 184 * MiB, WT_O = 200 * MiB, WT_LAYER = 232 * MiB;
constexpr size_t WS_HMOD = 480 * MiB;
constexpr size_t WS_PROJ = 544 * MiB;
constexpr size_t WS_G = 864 * MiB;
constexpr size_t WS_YS = 896 * MiB;
constexpr size_t WS_O4 = 928 * MiB;
constexpr size_t WS_YA = 1056 * MiB;
constexpr size_t WS_T = 1088 * MiB;
constexpr size_t WS_MRG = 1152 * MiB;
constexpr size_t WS_H1 = 1216 * MiB;
constexpr size_t WS_END = 1344 * MiB;
static_assert(WS_WT + 2 * WT_LAYER <= WS_HMOD && WS_S5P + 2 * 128 * 15360 <= WS_WT && WS_MODP + 2 * 16 * 2 * 12288 * 4 <= WS_MOD, "d_ws map");
constexpr int CW_TMO = 0, CW_CODE = 1;
constexpr int CW_BAR = 4096;

constexpr int RING_OFF = 0, RING_BYTES = 139264;
constexpr int LDSCTL_OFF = RING_BYTES, MISC_OFF = LDSCTL_OFF + 320;
constexpr int LDS_BYTES = 147456;
static_assert(MISC_OFF + 128 <= LDS_BYTES && att::LDS_BYTES <= RING_BYTES && s5::LDS_BYTES <= RING_BYTES && pg8::STAGE_BYTES <= RING_BYTES, "LDS map");
#define GAS __attribute__((address_space(1)))
#define LAS __attribute__((address_space(3)))
typedef unsigned short bf16;
typedef unsigned v4u __attribute__((ext_vector_type(4)));
typedef float f32x4 __attribute__((ext_vector_type(4)));
typedef short bf16x8 __attribute__((ext_vector_type(8)));
typedef GAS unsigned gu32;
typedef GAS unsigned long long gu64;
#define RLX_AGENT __ATOMIC_RELAXED, __HIP_MEMORY_SCOPE_AGENT
#define LDS_WAIT() asm volatile("s_waitcnt lgkmcnt(0)" ::: "memory")
#define VM_WAIT() asm volatile("s_waitcnt vmcnt(0)" ::: "memory")
__device__ __forceinline__ unsigned long long rt() { return __builtin_amdgcn_s_memrealtime(); }
__device__ __forceinline__ unsigned f2bf(float f) { unsigned u = __builtin_bit_cast(unsigned, f); return (u + 0x7fffu + ((u >> 16) & 1u)) >> 16; }
__device__ __forceinline__ unsigned pk2(float lo, float hi) { return f2bf(lo) | (f2bf(hi) << 16); }
#define XB_TMO      128
#define XB_XCNT(j)  (256  + 64 * (j))
#define XB_XSUB(j)  (1280 + 64 * (j))
#define XB_XGEN(j)  (2304 + 64 * (j))
#define XB_TOP      3328
#define XB_TOPGEN   3392
#define XCD_BAR_WORDS 3456
#define XB_SPIN_CAP (1u << 18)

__device__ __forceinline__ unsigned xb_ld(unsigned* p)              { return __hip_atomic_load(p, __ATOMIC_RELAXED, __HIP_MEMORY_SCOPE_AGENT); }
__device__ __forceinline__ unsigned xb_add(unsigned* p, unsigned v) { return __hip_atomic_fetch_add(p, v, __ATOMIC_RELAXED, __HIP_MEMORY_SCOPE_AGENT); }
__device__ __forceinline__ unsigned xb_xcc_id() { return (unsigned)__builtin_amdgcn_s_getreg((3 << 11) | 20) & 0xFu; }
#define XB_SPIN(cond, bar) do { unsigned _sp = 0; while (cond) { __builtin_amdgcn_s_sleep(1); \
    if ((++_sp & 255u) == 0u) { if (xb_ld(&(bar)[XB_TMO])) break; if (_sp > XB_SPIN_CAP) { atomicAdd(&(bar)[XB_TMO], 1u); break; } } } } while (0)

struct XcdBarrier {
    unsigned* bar; unsigned x;
    volatile LAS unsigned* st;
};

__device__ __forceinline__ XcdBarrier xcd_barrier_post(unsigned* bar, volatile LAS unsigned* st) {
    XcdBarrier b; b.bar = bar; b.x = xb_xcc_id(); b.st = st;
    if (threadIdx.x == 0) (void)xb_add(&bar[XB_XCNT(b.x)], 1u);
    return b;
}
__device__ __forceinline__ void xcd_barrier_complete(unsigned* bar, unsigned x, unsigned& nloc, unsigned& nx) {
    const unsigned G = gridDim.x * gridDim.y * gridDim.z;
    unsigned sum, cnt, mine, sp = 0u;
    for (;;) {
        sum = 0u; cnt = 0u; mine = 0u;
#pragma unroll
        for (unsigned j = 0; j < 16; ++j) { const unsigned c = xb_ld(&bar[XB_XCNT(j)]); sum += c; cnt += (c > 0u) ? 1u : 0u; mine = (j == x) ? c : mine; }
        if (sum == G) break;
        __builtin_amdgcn_s_sleep(1);
        if ((++sp & 255u) == 0u) { if (xb_ld(&bar[XB_TMO])) break; if (sp > XB_SPIN_CAP) { atomicAdd(&bar[XB_TMO], 1u); break; } }
    }
    nloc = mine > 0u ? mine : 1u; nx = cnt > 0u ? cnt : 1u;
}

__device__ __forceinline__ void xcd_barrier(const XcdBarrier& b) {
    asm volatile("s_waitcnt vmcnt(0)" ::: "memory");
    __syncthreads();
    if (threadIdx.x == 0) {
        unsigned* bar = b.bar;
        __builtin_amdgcn_s_waitcnt(0);
        unsigned nloc = b.st[0], nx = b.st[1];
        if (nloc == 0u) { xcd_barrier_complete(bar, b.x, nloc, nx); b.st[0] = nloc; b.st[1] = nx; }
        const unsigned old = xb_add(&bar[XB_XSUB(b.x)], 1u);
        const unsigned gen = old / nloc;
        if (old + 1u == (gen + 1u) * nloc) {
            __builtin_amdgcn_fence(__ATOMIC_RELEASE, "agent");
            asm volatile("s_waitcnt vmcnt(0)" ::: "memory");
            const unsigned og = xb_add(&bar[XB_TOP], 1u);
            const unsigned tg = og / nx;
            if (og + 1u == (tg + 1u) * nx) xb_add(&bar[XB_TOPGEN], 1u);
            else XB_SPIN(xb_ld(&bar[XB_TOPGEN]) == tg, bar);
            __builtin_amdgcn_fence(__ATOMIC_ACQUIRE, "agent");
            xb_add(&bar[XB_XGEN(b.x)], 1u);
            asm volatile("s_waitcnt vmcnt(0)" ::: "memory");
        } else {
            XB_SPIN(xb_ld(&bar[XB_XGEN(b.x)]) == gen, bar);
            __builtin_amdgcn_fence(__ATOMIC_ACQUIRE, "agent");
            asm volatile("s_waitcnt vmcnt(0)" ::: "memory");
        }
    }
    __syncthreads();
}
struct Frame {
    LAS unsigned char* lds;
    volatile LAS unsigned* MISC;
    gu32* ctl;
    int tid, lane, wave;
    int vcu, G;
    unsigned char* ws;
};
__device__ __forceinline__ float wave_sum(float v) {
#pragma unroll
    for (int o = 1; o < 64; o <<= 1) v += __shfl_xor(v, o);
    return v;
}
__device__ __forceinline__ float sigmoid_f(float x) { return __builtin_amdgcn_rcpf(1.0f + __builtin_amdgcn_exp2f(-1.4426950408889634f * x)); }
__device__ __forceinline__ float bflo(unsigned w) { return __uint_as_float(w << 16); }
__device__ __forceinline__ float bfhi(unsigned w) { return __uint_as_float(w & 0xffff0000u); }

__device__ __forceinline__ void p0_transpose_item(const float* W, int K, int N, bf16* WT, LAS float* scr, int item, int lane) {
    const int nblk = N / 64, kb = item / nblk, nb = item % nblk, k0 = 64 * kb, n0 = 64 * nb;
    const int kl = lane >> 4, nq = lane & 15;
    f32x4 v[16];
#pragma unroll
    for (int i = 0; i < 16; ++i) v[i] = *(const GAS f32x4*)(W + (size_t)(k0 + 4 * i + kl) * N + n0 + 4 * nq);
#pragma unroll
    for (int i = 0; i < 16; ++i) { LAS float* s = scr + (4 * i + kl) * 65 + 4 * nq; s[0] = v[i].x; s[1] = v[i].y; s[2] = v[i].z; s[3] = v[i].w; }
    LDS_WAIT(); asm volatile("" ::: "memory");
    const int c = lane & 7;
#pragma unroll
    for (int j = 0; j < 8; ++j) { const int n = (lane >> 3) + 8 * j; const LAS float* s = scr + (8 * c) * 65 + n;
        v4u o; o.x = pk2(s[0 * 65], s[1 * 65]); o.y = pk2(s[2 * 65], s[3 * 65]); o.z = pk2(s[4 * 65], s[5 * 65]); o.w = pk2(s[6 * 65], s[7 * 65]);
        *(GAS v4u*)(WT + (size_t)(n0 + n) * K + k0 + 8 * c) = o; }
    LDS_WAIT(); asm volatile("" ::: "memory");
}
__device__ __forceinline__ void p0_gemv_item(const float* Wl, const float* cvec, float* part, int cc, int ks, int lane) {
    f32x4 c0 = *(const GAS f32x4*)(cvec + 256 * ks + 4 * lane), c1 = *(const GAS f32x4*)(cvec + DM + 256 * ks + 4 * lane);
#pragma unroll
    for (int e = 0; e < 4; ++e) { c0[e] = c0[e] * sigmoid_f(c0[e]); c1[e] = c1[e] * sigmoid_f(c1[e]); }
    f32x4 a0 = {0.f, 0.f, 0.f, 0.f}, a1 = {0.f, 0.f, 0.f, 0.f};
    const float* wp = Wl + (size_t)(256 * ks) * 12288 + 256 * cc + 4 * lane;
    for (int s = 0; s < 64; s += 4) {
        f32x4 w[16];
#pragma unroll
        for (int i = 0; i < 16; ++i) w[i] = *(const GAS f32x4*)(wp + (size_t)(4 * s + i) * 12288);
#pragma unroll
        for (int i = 0; i < 16; ++i) { const int sl = s + (i >> 2), e = i & 3;
            const float ca = __uint_as_float(__builtin_amdgcn_readlane(__float_as_uint(c0[e]), sl)), cb = __uint_as_float(__builtin_amdgcn_readlane(__float_as_uint(c1[e]), sl));
            a0 = a0 + w[i] * ca; a1 = a1 + w[i] * cb; }
    }
    *(GAS f32x4*)(part + ((size_t)ks * 2 + 0) * 12288 + 256 * cc + 4 * lane) = a0;
    *(GAS f32x4*)(part + ((size_t)ks * 2 + 1) * 12288 + 256 * cc + 4 * lane) = a1;
}
__device__ __forceinline__ void sincos_d(double x, double& s, double& c) {
    const double kq = __builtin_rint(x * 0.63661977236758134308);
    double r = __builtin_fma(-kq, 1.57079632679489655800e+00, x); r = __builtin_fma(-kq, 6.12323399573676603587e-17, r);
    const double r2 = r * r;
    double ps = -1.0 / 355687428096000.0; ps = ps * r2 + 1.0 / 1307674368000.0; ps = ps * r2 - 1.0 / 6227020800.0; ps = ps * r2 + 1.0 / 39916800.0; ps = ps * r2 - 1.0 / 362880.0;
    ps = ps * r2 + 1.0 / 5040.0; ps = ps * r2 - 1.0 / 120.0; ps = ps * r2 + 1.0 / 6.0; ps = ps * r2 * (-r) + r;
    double pc = 1.0 / 20922789888000.0; pc = pc * r2 - 1.0 / 87178291200.0; pc = pc * r2 + 1.0 / 479001600.0; pc = pc * r2 - 1.0 / 3628800.0; pc = pc * r2 + 1.0 / 40320.0;
    pc = pc * r2 - 1.0 / 720.0; pc = pc * r2 + 1.0 / 24.0; pc = pc * r2 - 0.5; pc = pc * r2 + 1.0;
    const int qd = ((int)kq) & 3;
    s = (qd == 0) ? ps : (qd == 1) ? pc : (qd == 2) ? -ps : -pc;
    c = (qd == 0) ? pc : (qd == 1) ? -ps : (qd == 2) ? -pc : ps;
}
__device__ __forceinline__ double exp_small_d(double y) {
    double p = 1.0 / 3628800.0; p = p * y + 1.0 / 362880.0; p = p * y + 1.0 / 40320.0; p = p * y + 1.0 / 5040.0; p = p * y + 1.0 / 720.0; p = p * y + 1.0 / 120.0;
    p = p * y + 1.0 / 24.0; p = p * y + 1.0 / 6.0; p = p * y + 0.5; p = p * y + 1.0; p = p * y + 1.0; return p;
}
__device__ __forceinline__ void p0_s5_params(const float* const* in, unsigned char* ws, int idx) {
    const int l = idx >> 13, g = (idx >> 6) & 127, p = idx & 63, lg = l * NGRP + g;
    unsigned char* prm = ws + WS_S5P + (size_t)lg * s5::P_BYTES;
    const double lr = (double)in[I_LRE][lg * 64 + p], li = (double)in[I_LIM][lg * 64 + p];
    const double dt = (double)expf(in[I_LDT][lg]);
    const double mag = exp_small_d(lr * dt); double sn, cs; sincos_d(li * dt, sn, cs);
    const double are = mag * cs, aim = mag * sn;
    const double den = lr * lr + li * li, nre = are - 1.0;
    const double cre = (nre * lr + aim * li) / den, cim = (aim * lr - nre * li) / den;
    double pr = are, pi = aim;
#pragma unroll
    for (int i = 0; i < 8; ++i) { const double t = pr * pr - pi * pi; pi = 2.0 * pr * pi; pr = t; }
    { float* ab = (float*)(prm + s5::P_AB) + (p & 31) * 8 + (p >> 5) * 2; ab[0] = (float)are; ab[1] = (float)aim; ab[4] = (float)pr; ab[5] = (float)pi; }
    bf16* BF = (bf16*)(prm + s5::P_BF); bf16* CF = (bf16*)(prm + s5::P_CF); bf16* DF = (bf16*)(prm + s5::P_DF);
    const float* bre = in[I_BRE] + ((size_t)lg * 64 + p) * 16; const float* bim = in[I_BIM] + ((size_t)lg * 64 + p) * 16;
    const float* cr = in[I_CRE] + (size_t)lg * 16 * 64 + p; const float* ci = in[I_CIM] + (size_t)lg * 16 * 64 + p;
#pragma unroll
    for (int c = 0; c < 16; ++c) {
        const double br = (double)bre[c], bi = (double)bim[c];
        const float bbr = (float)(cre * br - cim * bi), bbi = (float)(cre * bi + cim * br);
        const int kg = c >> 3, e = c & 7;
        { const int pp = p;      BF[(((pp >> 5) * 64) + kg * 32 + (pp & 31)) * 8 + e] = (bf16)f2bf(bbr); }
        { const int pp = 64 + p; BF[(((pp >> 5) * 64) + kg * 32 + (pp & 31)) * 8 + e] = (bf16)f2bf(bbi); }
    }
#pragma unroll
    for (int c = 0; c < 32; ++c) {
        const float vr = c < 16 ? cr[(c & 15) * 64] : 0.f, vi = c < 16 ? -ci[(c & 15) * 64] : 0.f;
        { const int pp = p;      CF[((((pp >> 5) * 2 + ((pp >> 4) & 1)) * 64) + ((pp >> 3) & 1) * 32 + c) * 8 + (pp & 7)] = (bf16)f2bf(vr); }
        { const int pp = 64 + p; CF[((((pp >> 5) * 2 + ((pp >> 4) & 1)) * 64) + ((pp >> 3) & 1) * 32 + c) * 8 + (pp & 7)] = (bf16)f2bf(vi); }
    }
    {
        const int c = p & 31, kg = p >> 5;
#pragma unroll
        for (int e = 0; e < 8; ++e) { const int k = 8 * kg + e; float dv = (k == c && c < 16) ? in[I_SD][lg * 16 + (c & 15)] : 0.f;
            const unsigned hb = f2bf(dv); const float lo = dv - __uint_as_float(hb << 16);
            DF[p * 8 + e] = (bf16)hb; DF[(64 + p) * 8 + e] = (bf16)f2bf(lo); }
    }
}
__device__ __forceinline__ void p0_prologue(Frame& F, const float* const* in) {
    LAS float* scr = (LAS float*)(F.lds + RING_OFF + F.wave * 16640);
    const int gw = F.vcu * NWAVES + F.wave, NGW = F.G * NWAVES;
    constexpr int T_IN = (DM / 64) * (NIN / 64), T_GLU = (DSSM / 64) * (DSSM / 64), T_OS = (DSSM / 64) * (DM / 64), T_OA = (DATT / 64) * (DM / 64), T_O = (DM / 64) * (DM / 64);
    constexpr int T_LAYER = T_IN + T_GLU + T_OS + T_OA + T_O, N_GEMV = DEPTH * 48 * 16, N_S5 = DEPTH * NGRP, N_ITEMS = DEPTH * T_LAYER + N_GEMV + N_S5 + 1;
    for (int it = gw; it < N_ITEMS; it += NGW) {
        int r = it;
        if (r < DEPTH * T_LAYER) {
            const int l = r / T_LAYER; r -= l * T_LAYER; bf16* wt = (bf16*)(F.ws + WS_WT + (size_t)l * WT_LAYER);
            if (r < T_IN) { p0_transpose_item(in[I_WIN] + (size_t)l * DM * NIN, DM, NIN, wt + WT_IN / 2, scr, r, F.lane); continue; } r -= T_IN;
            if (r < T_GLU) { p0_transpose_item(in[I_WGLU] + (size_t)l * DSSM * DSSM, DSSM, DSSM, wt + WT_GLU / 2, scr, r, F.lane); continue; } r -= T_GLU;
            if (r < T_OS) { p0_transpose_item(in[I_WOS] + (size_t)l * DSSM * DM, DSSM, DM, wt + WT_OS / 2, scr, r, F.lane); continue; } r -= T_OS;
            if (r < T_OA) { p0_transpose_item(in[I_WOA] + (size_t)l * DATT * DM, DATT, DM, wt + WT_OA / 2, scr, r, F.lane); continue; } r -= T_OA;
            p0_transpose_item(in[I_WO] + (size_t)l * DM * DM, DM, DM, wt + WT_O / 2, scr, r, F.lane); continue;
        }
        r -= DEPTH * T_LAYER;
        if (r < N_GEMV) { const int l = r / (48 * 16), q = r % (48 * 16);
            p0_gemv_item(in[I_WADA] + (size_t)l * DM * 12288, in[I_C], (float*)(F.ws + WS_MODP) + (size_t)l * 16 * 2 * 12288, q % 48, q / 48, F.lane); continue; }
        r -= N_GEMV;
        if (r < N_S5) { p0_s5_params(in, F.ws, r * 64 + F.lane); continue; }
        {
            float* lut = (float*)(F.ws + WS_LUT);
            for (int i = F.lane; i < 8 * att::LUT_STRIDE; i += 64) { const int hh = i / att::LUT_STRIDE, d = i % att::LUT_STRIDE; float v = 0.f;
                if (d < 128) { int bk = d; if (d >= 16) { bk = 16 + (int)(logf((float)d / 16.0f) / 2.0794415416798357f * 16.0f); bk = bk > 31 ? 31 : bk; }
                    v = (in[I_RELB][bk * 8 + hh] - in[I_RELB][31 * 8 + hh]) * 11.313708498984761f; }
                lut[i] = v; }
        }
    }
}
__device__ __forceinline__ void p1_mod_finalize(Frame& F, const float* const* in) {
    const int t = F.vcu * (NWAVES * 64) + F.tid;
    if (t < DEPTH * BATCH * 12288) { const int l = t / (BATCH * 12288), r = t % (BATCH * 12288), b = r / 12288, j = r % 12288;
        const float* part = (const float*)(F.ws + WS_MODP) + (size_t)l * 16 * 2 * 12288 + (size_t)b * 12288 + j; float s = in[I_BADA][l * 12288 + j];
#pragma unroll
        for (int k = 0; k < 16; ++k) s += part[(size_t)k * 2 * 12288];
        ((float*)(F.ws + WS_MOD))[t] = s; }
}
__device__ __forceinline__ void pa_norm(Frame& F, const float* x, const float* g, const float* mod  , bf16* out) {
    const int gw = F.vcu * NWAVES + F.wave, NGW = F.G * NWAVES;
    for (int m = gw; m < M; m += NGW) {
        const GAS f32x4* xr = (const GAS f32x4*)(x + (size_t)m * DM) + F.lane;
        f32x4 v[16]; float s = 0.f;
#pragma unroll
        for (int j = 0; j < 16; ++j) { v[j] = xr[64 * j]; s += (v[j].x * v[j].x + v[j].y * v[j].y) + (v[j].z * v[j].z + v[j].w * v[j].w); }
        const float rstd = 1.0f / sqrtf(wave_sum(s) * (1.0f / DM) + EPS);
        const float* mb = mod + (size_t)(m / SEQ) * 12288;
        GAS unsigned long long* o8 = (GAS unsigned long long*)(out + (size_t)m * DM) + F.lane;
#pragma unroll
        for (int j = 0; j < 16; ++j) { const int col = 4 * (F.lane + 64 * j);
            const f32x4 gv = *(const GAS f32x4*)(g + col), sh = *(const GAS f32x4*)(mb + col), sc = *(const GAS f32x4*)(mb + DM + col);
            const f32x4 o = v[j] * rstd * gv * (sc + 1.0f) + sh;
            o8[64 * j] = (unsigned long long)pk2(o.x, o.y) | ((unsigned long long)pk2(o.z, o.w) << 32); }
    }
}
__device__ __forceinline__ void pz_final(Frame& F, float* h, const float* g) {
    const int gw = F.vcu * NWAVES + F.wave, NGW = F.G * NWAVES;
    for (int m = gw; m < M; m += NGW) {
        GAS f32x4* xr = (GAS f32x4*)(h + (size_t)m * DM) + F.lane;
        f32x4 v[16]; float s = 0.f;
#pragma unroll
        for (int j = 0; j < 16; ++j) { v[j] = xr[64 * j]; s += (v[j].x * v[j].x + v[j].y * v[j].y) + (v[j].z * v[j].z + v[j].w * v[j].w); }
        const float rstd = 1.0f / sqrtf(wave_sum(s) * (1.0f / DM) + EPS);
#pragma unroll
        for (int j = 0; j < 16; ++j) { const f32x4 gv = *(const GAS f32x4*)(g + 4 * (F.lane + 64 * j)); xr[64 * j] = v[j] * rstd * gv; }
    }
}
__device__ __forceinline__ void pd_combine(Frame& F, const float* O4, const bf16* proj, const float* const* in, int l, bf16* ya) {
    const float lam_init = (l == 0) ? 0.2f : 0.35550906759096926f;
    float d1 = 0.f, d2 = 0.f;
    { const float* q1 = in[I_LQ1] + l * 128; const float* k1 = in[I_LK1] + l * 128; const float* q2 = in[I_LQ2] + l * 128; const float* k2 = in[I_LK2] + l * 128;
      d1 = q1[F.lane] * k1[F.lane] + q1[F.lane + 64] * k1[F.lane + 64]; d2 = q2[F.lane] * k2[F.lane] + q2[F.lane + 64] * k2[F.lane + 64]; }
    const float lam = expf(wave_sum(d1)) - expf(wave_sum(d2)) + lam_init;
    const f32x4 sg = *(const GAS f32x4*)(in[I_SUBG] + l * 256 + 4 * F.lane) * (1.0f - lam_init);
    const int gw = F.vcu * NWAVES + F.wave, NGW = F.G * NWAVES;
    for (int it = gw; it < M * NHEAD; it += NGW) {
        const int m = it >> 3, hh = it & 7; const size_t off = (size_t)m * DATT + hh * 256 + 4 * F.lane;
        const f32x4 o0 = *(const GAS f32x4*)(O4 + off), o1 = *(const GAS f32x4*)(O4 + (size_t)M * DATT + off);
        const unsigned long long zz = *(const GAS unsigned long long*)(proj + (size_t)m * NIN + C_ZA + hh * 256 + 4 * F.lane);
        const f32x4 d = o0 - o1 * lam;
        const float rstd = 1.0f / sqrtf(wave_sum((d.x * d.x + d.y * d.y) + (d.z * d.z + d.w * d.w)) * (1.0f / 256.0f) + SUBLN_EPS);
        const unsigned zl = (unsigned)zz, zh = (unsigned)(zz >> 32);
        f32x4 z = {bflo(zl), bfhi(zl), bflo(zh), bfhi(zh)};
#pragma unroll
        for (int e = 0; e < 4; ++e) z[e] = z[e] * sigmoid_f(z[e]);
        const f32x4 o = d * rstd * sg * z;
        *(GAS unsigned long long*)(ya + off) = (unsigned long long)pk2(o.x, o.y) | ((unsigned long long)pk2(o.z, o.w) << 32);
    }
}

template <class T> __device__ __forceinline__ T* opq(T* p) { GAS T* g = (GAS T*)p; asm volatile("" : "+s"(g)); return (T*)g; }
struct Args { const float* in[N_INPUTS]; float* out; unsigned char* ws; int ph_lo, ph_hi; };
__global__ void __launch_bounds__(NWAVES * 64, 2) hybrid_fwd(Args args) {
    extern __shared__ __attribute__((aligned(16))) unsigned char lds[];
    Frame F;
    F.lds = (LAS unsigned char*)lds;
    F.MISC = (volatile LAS unsigned*)(F.lds + MISC_OFF);
    F.tid = threadIdx.x; F.lane = F.tid & 63; F.wave = __builtin_amdgcn_readfirstlane(F.tid >> 6);
    F.G = gridDim.x; { const int bx = blockIdx.x; F.vcu = (F.G % 8 == 0) ? (bx % 8) * (F.G / 8) + bx / 8 : bx; }
    F.ws = args.ws; F.ctl = (gu32*)(args.ws + WS_CTL);
    const float* const* in = args.in;
    for (int u = F.tid; u < (LDS_BYTES - LDSCTL_OFF) / 4; u += NWAVES * 64) ((LAS unsigned*)(F.lds + LDSCTL_OFF))[u] = 0u;
    __syncthreads();
    XcdBarrier bar; bar.bar = (unsigned*)(F.ctl + CW_BAR); bar.x = 0; bar.st = nullptr;
    if (!MK_SPLIT) bar = xcd_barrier_post((unsigned*)(F.ctl + CW_BAR), F.MISC + 8);
#define GRID_BAR(seam) do { if (MK_SPLIT) { if (F.tid == 0) __hip_atomic_store(F.ctl + CW_TMO, 0xBADBA0u | (unsigned)(seam), RLX_AGENT); } else { xcd_barrier(bar); } } while (0)
    const int lo = args.ph_lo, hi = args.ph_hi;
#define IN(k) (lo <= (k) && (k) < hi)
#ifndef PHMASK
#define PHMASK 0xFFFF
#endif
#define PHM(k) ((PHMASK >> (k)) & 1)
#define BOTH(k) (IN(k) && IN((k) + 1))
#define WSP(T, off) ((T*)(opq(args.ws) + (off)))
#define FRESH() do { F.tid = pg8::tidx(); F.lane = F.tid & 63; F.wave = __builtin_amdgcn_readfirstlane(F.tid >> 6); } while (0)
#define INP(i) (opq(args.in[i]))

    if (PHM(0) && IN(0)) { FRESH(); p0_prologue(F, in); if (BOTH(0)) GRID_BAR(0); }
    if (PHM(1) && IN(1)) { FRESH(); p1_mod_finalize(F, in); if (BOTH(1)) GRID_BAR(1); }

    for (int l = 0; l < DEPTH; ++l) {
        const int pb = 2 + 6 * l;
        if (PHM(2) && IN(pb)) { FRESH(); pa_norm(F, (l == 0) ? INP(I_X) : WSP(const float, WS_H1), INP(I_NORMG) + l * DM, WSP(const float, WS_MOD) + (size_t)l * BATCH * 12288, WSP(bf16, WS_HMOD)); if (BOTH(pb)) GRID_BAR(pb); }
        if (PHM(3) && IN(pb + 1)) {
            pg8::Gemm g{WSP(const bf16, WS_HMOD), WSP(const bf16, WS_WT + (size_t)l * WT_LAYER + WT_IN), M, NIN, DM}; pg8::StaticOrder S; S.init(M, NIN, F.G, (int)blockIdx.x);
            pg8::EpiBf16<0> E{WSP(bf16, WS_PROJ), NIN, nullptr, 0, 0, 1.f};
            pg8::gemm_phase<pg8::EpiBf16<0>, pg8::StaticOrder, true, true>(F.lds + RING_OFF, g, S, E);
            if (BOTH(pb + 1)) GRID_BAR(pb + 1);
        }
        if (PHM(4) && IN(pb + 2)) {
#ifndef NO_ATT
            att::attn_phase((char*)lds + RING_OFF, WSP(const bf16, WS_PROJ), WSP(float, WS_O4), WSP(const float, WS_LUT), F.vcu, F.G, C_Q, C_K, C_V);
#endif
#ifndef NO_S5
            for (int it = F.vcu; it < BATCH * NGRP; it += F.G)
                s5::s5_unit((char*)lds + RING_OFF, WSP(const bf16, WS_PROJ), WSP(bf16, WS_G), WSP(const char, WS_S5P) + (size_t)(l * NGRP + (it & 127)) * s5::P_BYTES, it >> 7, it & 127);
#endif
            if (BOTH(pb + 2)) GRID_BAR(pb + 2);
        }
        if (PHM(5) && IN(pb + 3)) {
            FRESH(); pd_combine(F, WSP(const float, WS_O4), WSP(const bf16, WS_PROJ), in, l, WSP(bf16, WS_YA));
            pg8::Gemm g{WSP(const bf16, WS_G), WSP(const bf16, WS_WT + (size_t)l * WT_LAYER + WT_GLU), M, DSSM, DSSM}; pg8::StaticOrder S; S.init(M, DSSM, F.G, (int)blockIdx.x);
            pg8::EpiGlu E{WSP(const bf16, WS_G), WSP(const bf16, WS_PROJ), WSP(bf16, WS_YS), C_ZS};
            pg8::gemm_phase<pg8::EpiGlu, pg8::StaticOrder, true, true>(F.lds + RING_OFF, g, S, E);
            if (BOTH(pb + 3)) GRID_BAR(pb + 3);
        }
        if (PHM(6) && IN(pb + 4)) {
            { pg8::Gemm g{WSP(const bf16, WS_YS), WSP(const bf16, WS_WT + (size_t)l * WT_LAYER + WT_OS), M, DM, DSSM}; pg8::StaticOrder S; S.init(M, DM, F.G, (int)blockIdx.x);
              pg8::EpiPs E{WSP(const bf16, WS_PROJ), WSP(bf16, WS_T), C_GS};
              pg8::gemm_phase<pg8::EpiPs, pg8::StaticOrder, true, true>(F.lds + RING_OFF, g, S, E); }
            VM_WAIT(); __syncthreads();
            { pg8::Gemm g{WSP(const bf16, WS_YA), WSP(const bf16, WS_WT + (size_t)l * WT_LAYER + WT_OA), M, DM, DATT}; pg8::StaticOrder S; S.init(M, DM, F.G, (int)blockIdx.x);
              pg8::EpiPa E{WSP(const bf16, WS_PROJ), WSP(const bf16, WS_T), WSP(bf16, WS_MRG), C_GA};
              pg8::gemm_phase<pg8::EpiPa, pg8::StaticOrder, true, true>(F.lds + RING_OFF, g, S, E); }
            if (BOTH(pb + 4)) GRID_BAR(pb + 4);
        }
        if (PHM(7) && IN(pb + 5)) {
            pg8::Gemm g{WSP(const bf16, WS_MRG), WSP(const bf16, WS_WT + (size_t)l * WT_LAYER + WT_O), M, DM, DM}; pg8::StaticOrder S; S.init(M, DM, F.G, (int)blockIdx.x);
            pg8::EpiRes E{(l == 0) ? INP(I_X) : WSP(const float, WS_H1), (l == 0) ? WSP(float, WS_H1) : opq(args.out), WSP(const float, WS_MOD) + (size_t)l * BATCH * 12288 + 2 * DM};
            pg8::gemm_phase<pg8::EpiRes, pg8::StaticOrder, true, true>(F.lds + RING_OFF, g, S, E);
            if (BOTH(pb + 5)) GRID_BAR(pb + 5);
        }
    }
    if (PHM(8) && IN(14)) { FRESH(); pz_final(F, opq(args.out), INP(I_FING)); }
#undef WSP
#undef FRESH
#undef INP
#undef IN
#undef BOTH
#undef GRID_BAR
}

extern "C" void kernel_launch(void* const* d_in, const int* in_sizes, int n_in, void* d_out, int out_size, void* d_ws, size_t ws_size, hipStream_t stream) {
    static int grid = 0;
    if (grid == 0) {
        if (n_in != N_INPUTS || in_sizes[0] != M * DM || out_size != M * DM || ws_size < WS_END) { fprintf(stderr, "kernel_launch: shape mismatch (n_in %d, in0 %d, out %d, ws %zu)\n", n_in, n_in > 0 ? in_sizes[0] : -1, out_size, ws_size); grid = -1; return; }
        int dev = 0, cus = 0, per_cu = 0;
        if (hipGetDevice(&dev) != hipSuccess || hipDeviceGetAttribute(&cus, hipDeviceAttributeMultiprocessorCount, dev) != hipSuccess) { grid = -1; return; }
        if (hipFuncSetAttribute((const void*)hybrid_fwd, hipFuncAttributeMaxDynamicSharedMemorySize, LDS_BYTES) != hipSuccess) { fprintf(stderr, "kernel_launch: hipFuncSetAttribute failed\n"); grid = -1; return; }
        if (hipOccupancyMaxActiveBlocksPerMultiprocessor(&per_cu, (const void*)hybrid_fwd, NWAVES * 64, LDS_BYTES) != hipSuccess || per_cu < 1)
            fprintf(stderr, "kernel_launch: note: occupancy query reports %d workgroups per CU\n", per_cu);
        (void)hipGetLastError();
        grid = cus;
    }
    if (grid < 0) return;
    if (hipMemsetAsync((char*)d_ws + WS_CTL, 0, CTL_ZERO_BYTES, stream) != hipSuccess) { fprintf(stderr, "kernel_launch: hipMemsetAsync failed\n"); return; }
    Args a{};
    for (int i = 0; i < N_INPUTS; ++i) a.in[i] = (const float*)d_in[i];
    a.out = (float*)d_out; a.ws = (unsigned char*)d_ws;
#if MK_SPLIT
    for (int ph = 0; ph < N_PHASES; ++ph) { a.ph_lo = ph; a.ph_hi = ph + 1; hipLaunchKernelGGL(hybrid_fwd, dim3(grid), dim3(NWAVES * 64), LDS_BYTES, stream, a); }
#else
    a.ph_lo = 0; a.ph_hi = N_PHASES;
    hipLaunchKernelGGL(hybrid_fwd, dim3(grid), dim3(NWAVES * 64), LDS_BYTES, stream, a);
#endif
    const hipError_t le = hipPeekAtLastError();
    if (le != hipSuccess) fprintf(stderr, "kernel_launch: launch failed: %s (grid %d)\n", hipGetErrorName(le), grid);
}
```

```cpp
#include <hip/hip_runtime.h>
#include <cstdio>
#include <cstdint>
#include <cmath>
#ifndef PADE
#define PADE 64
#endif
constexpr int P_DM = 4096 + PADE, P_DS = 2048 + PADE, P_IN = 20480 + PADE, P_O4 = 2048 + PADE / 2, P_H1 = 4096 + PADE / 2;
namespace pg8 {
#define PG8_LAS __attribute__((address_space(3)))
typedef unsigned short bf16_t;
typedef short bf16x8 __attribute__((ext_vector_type(8)));
typedef float f32x4 __attribute__((ext_vector_type(4)));
typedef unsigned u32x4 __attribute__((ext_vector_type(4)));
constexpr int BM = 256, BK = 64, HALF = 128, HTB = HALF * BK * 2  , STAGE_BYTES = 8 * HTB, NXCD = 8, WGM = 8;

__host__ __device__ __forceinline__ int lds_byte(int r, int c) { const int st = (r >> 4) * 2 + (c >> 5), rr = r & 15, cc = c & 31, ob = rr * 64 + cc * 2; return st * 1024 + (ob ^ (((ob >> 9) & 1) << 5)); }
__host__ __device__ __forceinline__ void stage_rc(int b, int& R, int& C) { const int st = b / 1024, sb = b % 1024, swz = sb ^ (((sb >> 9) & 1) << 5); R = (st >> 1) * 16 + swz / 64; C = (st & 1) * 32 + (swz % 64) / 2; }
__host__ __device__ __forceinline__ int perm32(int rho) { const int n = rho >> 4, i = rho & 15; return 8 * (i >> 2) + 4 * n + (i & 3); }

struct Unit { int pm, pn; };
struct Gemm { const bf16_t* A; const bf16_t* Bt; int M, N, K, lda, ldb; };

struct StaticOrder {
    int nM, nN, nwg, G, c;
    __host__ __device__ void init(int M, int N, int G_, int c_) { nM = M / BM; nN = N / BM; nwg = nM * nN; G = G_; c = c_; }
    __host__ __device__ bool next(int i, Unit& u) const {
        const long L = (long)i * G + c; if (L >= nwg) return false;
        int wgid = (int)L; { const int q = nwg / NXCD, r = nwg % NXCD, xcd = wgid % NXCD, off = wgid / NXCD; wgid = (xcd < r ? xcd * (q + 1) : r * (q + 1) + (xcd - r) * q) + off; }
        const int nig = WGM * nN, gid = wgid / nig, fm = gid * WGM, gsz = (nM - fm) < WGM ? (nM - fm) : WGM;
        u.pm = fm + ((wgid % nig) % gsz); u.pn = (wgid % nig) / gsz; return true;
    }
    __device__ __forceinline__ void a_ready(const Unit&) const {}
    __device__ __forceinline__ void done(const Unit&) const {}
};

__device__ __forceinline__ unsigned cvt_pk_bf16(float lo, float hi) { unsigned r; asm volatile("v_cvt_pk_bf16_f32 %0, %1, %2" : "=v"(r) : "v"(lo), "v"(hi)); return r; }
typedef float f32x2 __attribute__((ext_vector_type(2)));
__device__ __forceinline__ f32x2 gelu_pk(f32x2 v) {
    const f32x2 av = __builtin_elementwise_abs(v), d = av * 0.2316418882f + 1.0f;
    f32x2 t; t.x = __builtin_amdgcn_rcpf(d.x); t.y = __builtin_amdgcn_rcpf(d.y);
    f32x2 q = t * 0.5307027145f + (-0.7265760135f); q = q * t + 0.7107068705f; q = q * t + (-0.142248368f); q = q * t + 0.127414796f; q = q * t;
    const f32x2 s = (v * v) * (-0.72134752044f);
    f32x2 e; e.x = __builtin_amdgcn_exp2f(s.x); e.y = __builtin_amdgcn_exp2f(s.y);
    const f32x2 m = v * (q * e), r = v - m;
    f32x2 o; o.x = v.x < 0.f ? m.x : r.x; o.y = v.y < 0.f ? m.y : r.y; return o;
}

template <int ACT  > struct EpiBf16 {
    static constexpr bool PERM = true, AFTER_DRAIN = false; static_assert(ACT == 0 || ACT == 1, "EpiBf16: ACT is 0 (none) or 1 (gelu_pk)");
    bf16_t* O; int ldc; const float* bias; int split_cols; size_t split_stride; float scale0;
    __device__ __forceinline__ void operator()(const f32x4 (&acc)[2][2][4][2], const Unit& u, int wr, int wc, int fr, int fq) const {
        const int row0 = u.pm * BM + wr * 64 + fr; int colt = u.pn * BM; bf16_t* base = O;
        float sc = 1.f; if (split_cols) { const int t = colt / split_cols; base += (size_t)t * split_stride; colt -= t * split_cols; if (t == 0) sc = scale0; }
        const int col0 = colt + wc * 32 + 8 * fq, bcol0 = u.pn * BM + wc * 32 + 8 * fq;
        f32x4 bv[2][2];
#pragma unroll
        for (int bj = 0; bj < 2; ++bj)
#pragma unroll
            for (int n = 0; n < 2; ++n) bv[bj][n] = bias ? *(const f32x4*)(bias + bcol0 + bj * HALF + 4 * n) : (f32x4){0.f, 0.f, 0.f, 0.f};
#pragma unroll
        for (int ai = 0; ai < 2; ++ai)
#pragma unroll
            for (int m = 0; m < 4; ++m) { bf16_t* rowp = base + (size_t)(row0 + ai * HALF + m * 16) * ldc + col0;
#pragma unroll
                for (int bj = 0; bj < 2; ++bj) { f32x4 v0 = acc[ai][bj][m][0] + bv[bj][0], v1 = acc[ai][bj][m][1] + bv[bj][1];
                    if (ACT == 1) { f32x2 a = gelu_pk((f32x2){v0[0], v0[1]}), b = gelu_pk((f32x2){v0[2], v0[3]}), c = gelu_pk((f32x2){v1[0], v1[1]}), d = gelu_pk((f32x2){v1[2], v1[3]});
                        v0 = (f32x4){a.x, a.y, b.x, b.y}; v1 = (f32x4){c.x, c.y, d.x, d.y}; }
                    v0 = v0 * sc; v1 = v1 * sc; u32x4 w; w.x = cvt_pk_bf16(v0[0], v0[1]); w.y = cvt_pk_bf16(v0[2], v0[3]); w.z = cvt_pk_bf16(v1[0], v1[1]); w.w = cvt_pk_bf16(v1[2], v1[3]);
                    *(u32x4*)(rowp + bj * HALF) = w; } }
    }
};
__device__ __forceinline__ int tidx() { int t = (int)threadIdx.x; asm volatile("" : "+v"(t)); return t & 511; }
__device__ __forceinline__ float bf_lo(unsigned w) { return __uint_as_float(w << 16); }
__device__ __forceinline__ float bf_hi(unsigned w) { return __uint_as_float(w & 0xffff0000u); }
__device__ __forceinline__ float sigm(float x) { return __builtin_amdgcn_rcpf(1.0f + __builtin_amdgcn_exp2f(-1.4426950408889634f * x)); }
__device__ __forceinline__ void unpack8(const u32x4 w, float (&f)[8]) { f[0] = bf_lo(w.x); f[1] = bf_hi(w.x); f[2] = bf_lo(w.y); f[3] = bf_hi(w.y); f[4] = bf_lo(w.z); f[5] = bf_hi(w.z); f[6] = bf_lo(w.w); f[7] = bf_hi(w.w); }
__device__ __forceinline__ u32x4 pack8f(const float (&o)[8]) { u32x4 w; w.x = cvt_pk_bf16(o[0], o[1]); w.y = cvt_pk_bf16(o[2], o[3]); w.z = cvt_pk_bf16(o[4], o[5]); w.w = cvt_pk_bf16(o[6], o[7]); return w; }
#define PG8_EPI_ROWCOL const int row0 = u.pm * BM + wr * 64 + fr, col0 = u.pn * BM + wc * 32 + 8 * fq;
#define PG8_EPI_FOR_MB _Pragma("unroll") for (int m = 0; m < 4; ++m) _Pragma("unroll") for (int bj = 0; bj < 2; ++bj)
#define PG8_EPI_RC const size_t row = (size_t)(row0 + ai * HALF + m * 16); const int col = col0 + bj * HALF;
#define PG8_EPI_ACC const f32x4 v0 = acc[ai][bj][m][0], v1 = acc[ai][bj][m][1]; const float a[8] = {v0[0], v0[1], v0[2], v0[3], v1[0], v1[1], v1[2], v1[3]};
struct EpiGlu {
    static constexpr bool PERM = true, AFTER_DRAIN = false;
    const bf16_t* G; const bf16_t* P; bf16_t* YS; int zcol;
    __device__ __forceinline__ void operator()(const f32x4 (&acc)[2][2][4][2], const Unit& u, int wr, int wc, int fr, int fq) const {
        PG8_EPI_ROWCOL
#pragma unroll
        for (int ai = 0; ai < 2; ++ai) {
            u32x4 lg[4][2], lz[4][2];
            PG8_EPI_FOR_MB { PG8_EPI_RC lg[m][bj] = *(const u32x4*)(G + row * P_DS + col); lz[m][bj] = *(const u32x4*)(P + row * P_IN + zcol + col); }
            PG8_EPI_FOR_MB { PG8_EPI_RC PG8_EPI_ACC float g[8], z[8], o[8]; unpack8(lg[m][bj], g); unpack8(lz[m][bj], z);
#pragma unroll
                for (int e = 0; e < 8; ++e) o[e] = g[e] * sigm(a[e]) * (z[e] * sigm(z[e]));
                *(u32x4*)(YS + row * P_DS + col) = pack8f(o); }
            asm volatile("" ::: "memory");
        }
    }
};
struct EpiPs {
    static constexpr bool PERM = true, AFTER_DRAIN = false;
    const bf16_t* P; bf16_t* T; int gcol;
    __device__ __forceinline__ void operator()(const f32x4 (&acc)[2][2][4][2], const Unit& u, int wr, int wc, int fr, int fq) const {
        PG8_EPI_ROWCOL
#pragma unroll
        for (int ai = 0; ai < 2; ++ai) {
            u32x4 lg[4][2];
            PG8_EPI_FOR_MB { PG8_EPI_RC lg[m][bj] = *(const u32x4*)(P + row * P_IN + gcol + col); }
            PG8_EPI_FOR_MB { PG8_EPI_RC PG8_EPI_ACC float g[8], o[8]; unpack8(lg[m][bj], g);
#pragma unroll
                for (int e = 0; e < 8; ++e) o[e] = sigm(g[e]) * a[e];
                *(u32x4*)(T + row * P_DM + col) = pack8f(o); }
            asm volatile("" ::: "memory");
        }
    }
};
struct EpiPa {
    static constexpr bool PERM = true, AFTER_DRAIN = false;
    const bf16_t* P; const bf16_t* T; bf16_t* MG; int gcol;
    __device__ __forceinline__ void operator()(const f32x4 (&acc)[2][2][4][2], const Unit& u, int wr, int wc, int fr, int fq) const {
        PG8_EPI_ROWCOL
#pragma unroll
        for (int ai = 0; ai < 2; ++ai) {
            u32x4 lg[4][2], lt[4][2];
            PG8_EPI_FOR_MB { PG8_EPI_RC lg[m][bj] = *(const u32x4*)(P + row * P_IN + gcol + col); lt[m][bj] = *(const u32x4*)(T + row * P_DM + col); }
            PG8_EPI_FOR_MB { PG8_EPI_RC PG8_EPI_ACC float g[8], t[8], o[8]; unpack8(lg[m][bj], g); unpack8(lt[m][bj], t);
#pragma unroll
                for (int e = 0; e < 8; ++e) o[e] = t[e] + sigm(g[e]) * a[e];
                *(u32x4*)(MG + row * P_DM + col) = pack8f(o); }
            asm volatile("" ::: "memory");
        }
    }
};
struct EpiRes {
    static constexpr bool PERM = true, AFTER_DRAIN = false;
    const float* R; float* O; const float* gate; int ldr, ldo;
    __device__ __forceinline__ void operator()(const f32x4 (&acc)[2][2][4][2], const Unit& u, int wr, int wc, int fr, int fq) const {
        const float* gt = gate + (size_t)(u.pm >> 4) * 12288;
        PG8_EPI_ROWCOL
        f32x4 g0[2], g1[2];
#pragma unroll
        for (int bj = 0; bj < 2; ++bj) { g0[bj] = *(const f32x4*)(gt + col0 + bj * HALF); g1[bj] = *(const f32x4*)(gt + col0 + bj * HALF + 4); }
#pragma unroll
        for (int ai = 0; ai < 2; ++ai) {
            f32x4 r0[4][2], r1[4][2];
            PG8_EPI_FOR_MB { PG8_EPI_RC r0[m][bj] = *(const f32x4*)(R + row * ldr + col); r1[m][bj] = *(const f32x4*)(R + row * ldr + col + 4); }
            PG8_EPI_FOR_MB { PG8_EPI_RC *(f32x4*)(O + row * ldo + col) = r0[m][bj] + g0[bj] * acc[ai][bj][m][0]; *(f32x4*)(O + row * ldo + col + 4) = r1[m][bj] + g1[bj] * acc[ai][bj][m][1]; }
            asm volatile("" ::: "memory");
        }
    }
};
template <class Epi, class Sched, bool ALIGN_EPI = false, bool SP2 = false>
__device__ __forceinline__ void gemm_phase(PG8_LAS unsigned char* lds, const Gemm g, const Sched& S, const Epi& E) {
    const int tid = pg8::tidx(), wid = __builtin_amdgcn_readfirstlane(tid >> 6), lane = tid & 63, wr = wid >> 2, wc = wid & 3, fr = lane & 15, fq = lane >> 4;
    const int K = g.K, nt = K / BK;
    unsigned voffA[2], voffB[2];
#pragma unroll
    for (int i = 0; i < 2; ++i) { int R, C; stage_rc(tid * 16 + i * 8192, R, C); const int Rb = Epi::PERM ? ((R & ~31) + perm32(R & 31)) : R;
        voffA[i] = (unsigned)(R * g.lda + C) * 2u; voffB[i] = (unsigned)(Rb * g.ldb + C) * 2u; }
    const size_t kstep = (size_t)(BK * 2);
    const size_t hstepA = (size_t)HALF * g.lda * 2, hstepB = (size_t)HALF * g.ldb * 2;
    const size_t tstepA = 2 * hstepA, tstepB = 2 * hstepB;
    const unsigned ldsw = (unsigned)wid * 1024u;
    const int aoff = lds_byte(wr * 64 + fr, fq * 8), boff = lds_byte(wc * 32 + fr, fq * 8);
#define PG8_SA(b, h) (((b) * 2 + (h)) * HTB)
#define PG8_SB(b, h) ((4 + (b) * 2 + (h)) * HTB)
#define PG8_STAGE(bufoff, gbase, voff) do { _Pragma("unroll") for (int _i = 0; _i < 2; ++_i) \
        __builtin_amdgcn_global_load_lds((const unsigned*)((const char*)(gbase) + (voff)[_i]), (PG8_LAS unsigned*)(lds + (bufoff) + ldsw + _i * 8192), 16, 0, 0); } while (0)
#define PG8_LDA(dst, b, h) do { _Pragma("unroll") for (int m = 0; m < 4; ++m) _Pragma("unroll") for (int k = 0; k < 2; ++k) dst[m][k] = *(const PG8_LAS bf16x8*)(lds + PG8_SA(b, h) + aoff + m * 2048 + k * 1024); } while (0)
#define PG8_LDB(dst, b, h) do { _Pragma("unroll") for (int n = 0; n < 2; ++n) _Pragma("unroll") for (int k = 0; k < 2; ++k) dst[n][k] = *(const PG8_LAS bf16x8*)(lds + PG8_SB(b, h) + boff + n * 2048 + k * 1024); } while (0)
#define PG8_MMA(ai, bj, At, Bt) do { __builtin_amdgcn_s_setprio(1); _Pragma("unroll") for (int m = 0; m < 4; ++m) _Pragma("unroll") for (int n = 0; n < 2; ++n) _Pragma("unroll") for (int k = 0; k < 2; ++k) \
        acc[ai][bj][m][n] = __builtin_amdgcn_mfma_f32_16x16x32_bf16(Bt[n][k], At[m][k], acc[ai][bj][m][n], 0, 0, 0); __builtin_amdgcn_s_setprio(0); } while (0)
#define PG8_WAIT_V(n) asm volatile("s_waitcnt vmcnt(" #n ")" ::: "memory")
#define PG8_WAIT_L(n) asm volatile("s_waitcnt lgkmcnt(" #n ")" ::: "memory")
#define PG8_BAR __builtin_amdgcn_s_barrier()
#define PG8_SCHED __builtin_amdgcn_sched_barrier(0)
    Unit cur, nxt; int ui = 0;
    if (!S.next(0, cur)) return;
    f32x4 acc[2][2][4][2];
#pragma unroll
    for (int a = 0; a < 2; ++a)
#pragma unroll
        for (int b = 0; b < 2; ++b)
#pragma unroll
            for (int m = 0; m < 4; ++m)
#pragma unroll
                for (int n = 0; n < 2; ++n) acc[a][b][m][n] = (f32x4){0.f, 0.f, 0.f, 0.f};
    bf16x8 At[4][2], B0[2][2], B1[2][2];
    const char* cA = (const char*)g.A + (size_t)cur.pm * tstepA; const char* cB = (const char*)g.Bt + (size_t)cur.pn * tstepB;
    S.a_ready(cur);
    if constexpr (SP2) {
        PG8_STAGE(PG8_SB(0, 0), cB, voffB); PG8_STAGE(PG8_SB(0, 1), cB + hstepB, voffB); PG8_STAGE(PG8_SA(0, 0), cA, voffA); PG8_STAGE(PG8_SA(0, 1), cA + hstepA, voffA);
        if (wr == 1) PG8_BAR;
        PG8_WAIT_V(2); PG8_BAR;
        PG8_STAGE(PG8_SB(1, 0), cB + kstep, voffB); PG8_STAGE(PG8_SA(1, 0), cA + kstep, voffA); PG8_STAGE(PG8_SB(1, 1), cB + hstepB + kstep, voffB);
        PG8_WAIT_V(6); PG8_BAR;
    } else {
        PG8_STAGE(PG8_SB(0, 0), cB, voffB); PG8_STAGE(PG8_SA(0, 0), cA, voffA); PG8_STAGE(PG8_SB(0, 1), cB + hstepB, voffB); PG8_STAGE(PG8_SA(0, 1), cA + hstepA, voffA);
        if (wr == 1) PG8_BAR;
        PG8_WAIT_V(4); PG8_BAR;
        PG8_STAGE(PG8_SB(1, 0), cB + kstep, voffB); PG8_STAGE(PG8_SA(1, 0), cA + kstep, voffA); PG8_STAGE(PG8_SB(1, 1), cB + hstepB + kstep, voffB);
        PG8_WAIT_V(6); PG8_BAR;
    }
    for (;;) {
        const bool has_next = S.next(ui + 1, nxt);
        const char* nA = has_next ? (const char*)g.A + (size_t)nxt.pm * tstepA : cA; const char* nB = has_next ? (const char*)g.Bt + (size_t)nxt.pn * tstepB : cB;
        for (int t = 0; t < nt; t += 2) {
            const bool last = (t == nt - 2);
            const char* a1 = cA + (size_t)(t + 1) * kstep;
            const char* a2 = last ? nA : cA + (size_t)(t + 2) * kstep; const char* b2 = last ? nB : cB + (size_t)(t + 2) * kstep;
            const char* a3 = a2 + kstep; const char* b3 = b2 + kstep;
            if (last && has_next) S.a_ready(nxt);
            if constexpr (SP2) {
            PG8_LDB(B0, 0, 0); PG8_LDB(B1, 0, 1); PG8_SCHED; PG8_LDA(At, 0, 0); PG8_STAGE(PG8_SA(1, 1), a1 + hstepA, voffA);
            PG8_WAIT_V(8); PG8_WAIT_L(0); PG8_BAR; PG8_MMA(0, 0, At, B0); PG8_MMA(0, 1, At, B1); PG8_BAR; PG8_SCHED;
            PG8_LDA(At, 0, 1); PG8_STAGE(PG8_SB(0, 0), b2, voffB); PG8_STAGE(PG8_SB(0, 1), b2 + hstepB, voffB); PG8_STAGE(PG8_SA(0, 0), a2, voffA);
            PG8_WAIT_V(8); PG8_WAIT_L(0); PG8_BAR; PG8_MMA(1, 0, At, B0); PG8_MMA(1, 1, At, B1); PG8_BAR; PG8_SCHED;
            PG8_LDB(B0, 1, 0); PG8_LDB(B1, 1, 1); PG8_SCHED; PG8_LDA(At, 1, 0); PG8_STAGE(PG8_SA(0, 1), a2 + hstepA, voffA);
            PG8_WAIT_V(8); PG8_WAIT_L(0); PG8_BAR; PG8_MMA(0, 0, At, B0); PG8_MMA(0, 1, At, B1); PG8_BAR; PG8_SCHED;
            PG8_LDA(At, 1, 1); PG8_STAGE(PG8_SB(1, 0), b3, voffB); PG8_STAGE(PG8_SB(1, 1), b3 + hstepB, voffB); PG8_STAGE(PG8_SA(1, 0), a3, voffA);
            PG8_WAIT_V(8); PG8_WAIT_L(0); PG8_BAR; PG8_MMA(1, 0, At, B0); PG8_MMA(1, 1, At, B1); PG8_BAR; PG8_SCHED;
            } else {
            PG8_LDB(B0, 0, 0); PG8_SCHED; PG8_LDA(At, 0, 0); PG8_STAGE(PG8_SA(1, 1), a1 + hstepA, voffA);
            PG8_WAIT_L(8); PG8_BAR; PG8_WAIT_L(0); PG8_MMA(0, 0, At, B0); PG8_BAR; PG8_SCHED;
            PG8_LDB(B1, 0, 1); PG8_STAGE(PG8_SB(0, 0), b2, voffB);
            PG8_BAR; PG8_WAIT_L(0); PG8_MMA(0, 1, At, B1); PG8_BAR;
            PG8_LDA(At, 0, 1); PG8_STAGE(PG8_SA(0, 0), a2, voffA);
            PG8_BAR; PG8_WAIT_L(0); PG8_MMA(1, 0, At, B0); PG8_BAR; PG8_SCHED;
            PG8_STAGE(PG8_SB(0, 1), b2 + hstepB, voffB);
            PG8_WAIT_V(6); PG8_BAR; PG8_MMA(1, 1, At, B1); PG8_BAR;
            PG8_LDB(B0, 1, 0); PG8_SCHED; PG8_LDA(At, 1, 0); PG8_STAGE(PG8_SA(0, 1), a2 + hstepA, voffA);
            PG8_WAIT_L(8); PG8_BAR; PG8_WAIT_L(0); PG8_MMA(0, 0, At, B0); PG8_BAR; PG8_SCHED;
            PG8_LDB(B1, 1, 1); PG8_STAGE(PG8_SB(1, 0), b3, voffB);
            PG8_BAR; PG8_WAIT_L(0); PG8_MMA(0, 1, At, B1); PG8_BAR;
            PG8_LDA(At, 1, 1); PG8_STAGE(PG8_SA(1, 0), a3, voffA);
            PG8_BAR; PG8_WAIT_L(0); PG8_MMA(1, 0, At, B0); PG8_BAR; PG8_SCHED;
            PG8_STAGE(PG8_SB(1, 1), b3 + hstepB, voffB);
            PG8_WAIT_V(6); PG8_BAR; PG8_MMA(1, 1, At, B1); PG8_BAR;
            }
        }
        if constexpr (ALIGN_EPI) { if (wr == 0) PG8_BAR; }
        if constexpr (!Epi::AFTER_DRAIN) { E(acc, cur, wr, wc, fr, fq); S.done(cur); }
        if (!has_next) break;
#pragma unroll
        for (int a = 0; a < 2; ++a)
#pragma unroll
            for (int b = 0; b < 2; ++b)
#pragma unroll
                for (int m = 0; m < 4; ++m)
#pragma unroll
                    for (int n = 0; n < 2; ++n) acc[a][b][m][n] = (f32x4){0.f, 0.f, 0.f, 0.f};
        cur = nxt; cA = nA; cB = nB; ++ui;
        if constexpr (ALIGN_EPI) { if (wr == 1) PG8_BAR; }
    }
    PG8_WAIT_V(0);
    if constexpr (!ALIGN_EPI) { if (wr == 0) PG8_BAR; }
    PG8_BAR;
    if constexpr (Epi::AFTER_DRAIN) { E.fused(acc, cur, wr, wc, fr, fq, lds, wid, lane); S.done(cur); }
#undef PG8_SA
#undef PG8_SB
#undef PG8_STAGE
#undef PG8_LDA
#undef PG8_LDB
#undef PG8_MMA
#undef PG8_WAIT_V
#undef PG8_WAIT_L
#undef PG8_BAR
#undef PG8_SCHED
}
}
namespace att {
typedef unsigned short bf16;
typedef short bf16x8 __attribute__((ext_vector_type(8)));
typedef short s16x4 __attribute__((ext_vector_type(4)));
typedef float f32x16 __attribute__((ext_vector_type(16)));
typedef float f32x4 __attribute__((ext_vector_type(4)));
typedef unsigned u32x4 __attribute__((ext_vector_type(4)));
constexpr int D = 128, PITCH = P_IN, OPITCH = P_O4, SKV = 4096;
constexpr float THR = 8.f;
constexpr float SCALE = 0.08838834764831845f;
constexpr int NW = 8, QBLK = 32, KVBLK = 64, QB = NW * QBLK;
constexpr int SHM_V = KVBLK * D * 2, SHM_K = KVBLK * D * 2;
constexpr int LDS_WS = 2 * SHM_V + 2 * SHM_K, LDS_LUT = LDS_WS + NW * 64 * 4, LUT_STRIDE = 132  , LUTX = 480, LUTX_ZERO = 256  , LDS_BYTES = LDS_LUT + 8 * LUTX * 4;

#define KSWZ(row, colB) ((row) * 256 + ((colB) ^ (((row) & 7) << 4)))
#define SBAR() __builtin_amdgcn_sched_barrier(0)
__device__ __forceinline__ int v_st(int k, int c) { const int kk = (k & ~0xC) | ((k & 4) << 1) | ((k & 8) >> 1); return ((kk >> 3) * 4 + (c >> 5)) * 512 + ((kk & 7) * 32 + (c & 31)) * 2; }
__device__ __forceinline__ int v_rd_base(int lane) { return ((lane & 3) << 3) | (((lane >> 2) & 3) << 6) | (((lane >> 4) & 1) << 5) | (((lane >> 5) & 1) << 8); }
constexpr int v_rd_off(int d0, int ks, int half) { return d0 * 512 + ks * 4096 + half * 2048; }
__device__ __forceinline__ int crow(int r, int hi) { return (r & 3) + 8 * (r >> 2) + 4 * hi; }
__device__ __forceinline__ unsigned cvtpk(float lo, float hi) { unsigned r; asm volatile("v_cvt_pk_bf16_f32 %0, %1, %2" : "=v"(r) : "v"(lo), "v"(hi)); return r; }
__device__ __forceinline__ bf16x8 load8(const bf16* p) { return *reinterpret_cast<const bf16x8*>(p); }
__device__ __forceinline__ __amdgpu_buffer_rsrc_t mkrsrc(const void* p) { return __builtin_amdgcn_make_buffer_rsrc((void*)p, 0, 0x7fffffff, 0x00020000); }
__device__ __forceinline__ bf16x8 bload(__amdgpu_buffer_rsrc_t r, unsigned voff, unsigned soff) { return __builtin_bit_cast(bf16x8, __builtin_amdgcn_raw_buffer_load_b128(r, voff, soff, 0)); }
__device__ __forceinline__ void mask_bias_tile(f32x16& p0, f32x16& p1, const float* lp) {
#pragma unroll
    for (int r = 0; r < 16; ++r) {
        const int c = (r & 3) + 8 * (r >> 2);
        p0[r] += lp[59 - c];
        p1[r] += lp[59 - c - 32];
    }
}
__device__ __forceinline__ void partialSM(f32x16& p0, f32x16& p1, float& m_reg, float& mn, float& alpha) {
    float pmax = p0[0]; for (int r = 1; r < 16; ++r) pmax = fmaxf(pmax, p0[r]); for (int r = 0; r < 16; ++r) pmax = fmaxf(pmax, p1[r]);
    { auto rr = __builtin_amdgcn_permlane32_swap(__float_as_uint(pmax), __float_as_uint(pmax), false, false);
      pmax = fmaxf(__uint_as_float(rr[0]), __uint_as_float(rr[1])); }
    constexpr float C2 = 1.4426950408889634f * SCALE;
    if (__builtin_expect(__all((pmax - m_reg) * SCALE <= THR), 1)) { mn = m_reg; alpha = 1.f; }
    else { mn = fmaxf(m_reg, pmax); alpha = __builtin_amdgcn_exp2f((m_reg - mn) * C2); m_reg = mn; }
    const float mnL = -mn * C2;
    for (int r = 0; r < 16; ++r) p0[r] = fmaf(p0[r], C2, mnL); for (int r = 0; r < 16; ++r) p1[r] = fmaf(p1[r], C2, mnL);
    for (int r = 0; r < 16; ++r) p0[r] = __builtin_amdgcn_exp2f(p0[r]);
}
__device__ __forceinline__ void finishSM(f32x16& p0, f32x16& p1, float alpha, float& l_reg, bf16x8& pa0, bf16x8& pa1, bf16x8& pa2, bf16x8& pa3) {
    for (int r = 0; r < 16; ++r) p1[r] = __builtin_amdgcn_exp2f(p1[r]);
    float ps = 0; for (int r = 0; r < 16; ++r) ps += p0[r]; for (int r = 0; r < 16; ++r) ps += p1[r];
    { auto rr = __builtin_amdgcn_permlane32_swap(__float_as_uint(ps), __float_as_uint(ps), false, false);
      ps = __uint_as_float(rr[0]) + __uint_as_float(rr[1]); }
    l_reg = l_reg * alpha + ps;
#define PK4(P, B_, OUT) do { unsigned a0 = cvtpk(P[B_+0], P[B_+1]), a1 = cvtpk(P[B_+2], P[B_+3]);                          \
        unsigned b0 = cvtpk(P[B_+4], P[B_+5]), b1 = cvtpk(P[B_+6], P[B_+7]);                                             \
        auto r0 = __builtin_amdgcn_permlane32_swap(a0, b0, false, false); auto r1 = __builtin_amdgcn_permlane32_swap(a1, b1, false, false); \
        u32x4 w = {r0[0], r1[0], r0[1], r1[1]}; OUT = *reinterpret_cast<bf16x8*>(&w); } while (0)
    PK4(p0, 0, pa0); PK4(p0, 8, pa1); PK4(p1, 0, pa2); PK4(p1, 8, pa3);
#undef PK4
}
template <int KB>
__device__ __forceinline__ void qkt(f32x16& p0, f32x16& p1, const char* K_lds, int r32, int hi, const bf16x8* qr) {
    p0 = f32x16{}; p1 = f32x16{};
    const char* kb[4];
#pragma unroll
    for (int dd = 0; dd < 4; ++dd) kb[dd] = K_lds + KB * SHM_K + KSWZ(r32, (dd * 16 + hi * 8) * 2);
#pragma unroll
    for (int d0 = 0; d0 < 8; ++d0) { const char* a = kb[d0 & 3] + (d0 >> 2) * 128;
        bf16x8 b0 = *reinterpret_cast<const bf16x8*>(a);
        bf16x8 b1 = *reinterpret_cast<const bf16x8*>(a + 32 * 256);
        p0 = __builtin_amdgcn_mfma_f32_32x32x16_bf16(b0, qr[d0], p0, 0, 0, 0);
        p1 = __builtin_amdgcn_mfma_f32_32x32x16_bf16(b1, qr[d0], p1, 0, 0, 0); }
}
template <int VB>
__device__ __forceinline__ void pv_tile(f32x16* o, int vb0, bf16x8 pa0, bf16x8 pa1, bf16x8 pa2, bf16x8 pa3) {
#define TRRD(dst, off) asm volatile("ds_read_b64_tr_b16 %0, %1 offset:%2" : "=&v"(dst) : "v"(vb0), "i"(off) : "memory")
#define PV_D0(d0) do { s16x4 l0, l1, l2, l3, h0, h1, h2, h3; constexpr int b_ = VB * SHM_V + v_rd_off(d0, 0, 0);   \
        TRRD(l0, b_); TRRD(h0, b_ + 2048); TRRD(l1, b_ + 4096); TRRD(h1, b_ + 6144); TRRD(l2, b_ + 8192); TRRD(h2, b_ + 10240); TRRD(l3, b_ + 12288); TRRD(h3, b_ + 14336); \
        asm volatile("s_waitcnt lgkmcnt(0)" ::: "memory"); SBAR();                                                   \
        o[d0] = __builtin_amdgcn_mfma_f32_32x32x16_bf16(pa0, (bf16x8){l0[0], l0[1], l0[2], l0[3], h0[0], h0[1], h0[2], h0[3]}, o[d0], 0, 0, 0);   \
        o[d0] = __builtin_amdgcn_mfma_f32_32x32x16_bf16(pa1, (bf16x8){l1[0], l1[1], l1[2], l1[3], h1[0], h1[1], h1[2], h1[3]}, o[d0], 0, 0, 0);   \
        o[d0] = __builtin_amdgcn_mfma_f32_32x32x16_bf16(pa2, (bf16x8){l2[0], l2[1], l2[2], l2[3], h2[0], h2[1], h2[2], h2[3]}, o[d0], 0, 0, 0);   \
        o[d0] = __builtin_amdgcn_mfma_f32_32x32x16_bf16(pa3, (bf16x8){l3[0], l3[1], l3[2], l3[3], h3[0], h3[1], h3[2], h3[3]}, o[d0], 0, 0, 0); } while (0)
    PV_D0(0); PV_D0(1); PV_D0(2); PV_D0(3);
#undef PV_D0
#undef TRRD
}

struct BlockRef { const bf16* Q; const bf16* K; const bf16* V; float* O; int P0; int lut_off; };
struct Seam { bf16x8 qr[8]; bf16x8 st_v0, st_v1, st_k0, st_k1; };
#define VMW() asm volatile("s_waitcnt vmcnt(0)" ::: "memory")
#define VMWN(n) asm volatile("s_waitcnt vmcnt(%0)" :: "i"(n) : "memory")
#define SLOAD_H(rK_, rV_, k0) do { const unsigned so_ = (unsigned)(k0) * (unsigned)(PITCH * 2); S.st_v0 = bload(rV_, goff0, so_); S.st_v1 = bload(rV_, goff1, so_);              \
                         S.st_k0 = bload(rK_, goff0, so_); S.st_k1 = bload(rK_, goff1, so_); } while (0)
#define SWRITE_HK(bf) do { *(bf16x8*)(K_lds + (bf) * SHM_K + kws) = S.st_k0; *(bf16x8*)(K_lds + (bf) * SHM_K + kws + 32 * 256) = S.st_k1; } while (0)
#define SWRITE_HV(bf) do { *(bf16x8*)(V_lds + (bf) * SHM_V + vst0) = S.st_v0; *(bf16x8*)(V_lds + (bf) * SHM_V + vst1) = S.st_v1; } while (0)
#define SWRITE_H(bf) do { SWRITE_HV(bf); SWRITE_HK(bf); } while (0)
__device__ __forceinline__ void attn_prime(const BlockRef& cur, char* lds, Seam& S) {
    const int tid = pg8::tidx(), wid = __builtin_amdgcn_readfirstlane(tid >> 6), lane = tid & 63, r32 = lane & 31, hi = lane >> 5;
    const int sr = tid >> 4, sc = (tid & 15) * 8, kws = KSWZ(sr, sc * 2); char* K_lds = lds + 2 * SHM_V;
    const unsigned goff0 = (unsigned)(sr * PITCH + sc) * 2u, goff1 = goff0 + 32u * PITCH * 2u, qoff = (unsigned)((wid * QBLK + r32) * PITCH + hi * 8) * 2u;
    { const __amdgpu_buffer_rsrc_t rQ = mkrsrc(cur.Q), rK = mkrsrc(cur.K), rV = mkrsrc(cur.V);
      for (int d0 = 0; d0 < 8; ++d0) S.qr[d0] = bload(rQ, qoff + d0 * 32, 0);
      SLOAD_H(rK, rV, 0); } VMW(); SWRITE_HK(0);
    __syncthreads();
}
__device__ __forceinline__ void attn_block(const BlockRef& cur, const BlockRef& nxt, char* lds, Seam& S) {
    const int tid = pg8::tidx(), wid = __builtin_amdgcn_readfirstlane(tid >> 6), lane = tid & 63, r32 = lane & 31, hi = lane >> 5;
    const int NT = (cur.P0 + QB) / KVBLK;
    const int qlo = cur.P0 + wid * QBLK, qm = qlo + r32 - 4 * hi;
    char* V_lds = lds; char* K_lds = lds + 2 * SHM_V;
    float* ws = (float*)(lds + LDS_WS) + wid * 64; float* li_l = ws, * al_l = ws + 32;
    const float* lut = (const float*)(lds + cur.lut_off) + (LUTX_ZERO - 59) + qm;
    float m_reg = -1e30f, l_reg = 0; f32x16 o[4] = {};
    const int sr = tid >> 4, sc = (tid & 15) * 8, vst0 = v_st(sr, sc), vst1 = v_st(32 + sr, sc), kws = KSWZ(sr, sc * 2);
    const unsigned goff0 = (unsigned)(sr * PITCH + sc) * 2u, goff1 = goff0 + 32u * PITCH * 2u, qoff = (unsigned)((wid * QBLK + r32) * PITCH + hi * 8) * 2u;
    const int vb0 = (int)(uintptr_t)V_lds + v_rd_base(lane);
    const __amdgpu_buffer_rsrc_t Kh = mkrsrc(cur.K), Vh = mkrsrc(cur.V);
#define RESC(a) do { if (__any((a) < 1.f)) { if (hi == 0) al_l[r32] = (a); asm volatile("s_waitcnt lgkmcnt(0)" ::: "memory");              \
                     for (int d_ = 0; d_ < 4; ++d_) for (int r = 0; r < 16; ++r) o[d_][r] *= al_l[crow(r, hi)]; } } while (0)
#define KBASE(t) ((t) * KVBLK)
#define MASKT(P0_, P1_, t) do { const int kb_ = KBASE(t); if (kb_ + KVBLK - 1 + 128 > qlo) mask_bias_tile(P0_, P1_, lut - kb_); } while (0)
    constexpr int NQL = 8;
#define SEAM_K0() do { VMWN(NQL); SWRITE_HK(0); SBAR(); } while (0)
    f32x16 pA0, pA1, pB0, pB1; float mnA, mnB, alA, alB; bf16x8 pa0, pa1, pa2, pa3;
    SWRITE_HV(0); SBAR();
    if (NT > 1) { SLOAD_H(Kh, Vh, KBASE(1)); }
    SBAR(); qkt<0>(pA0, pA1, K_lds, r32, hi, S.qr);
    MASKT(pA0, pA1, 0); partialSM(pA0, pA1, m_reg, mnA, alA);
    if (NT > 1) { VMW(); SWRITE_H(1); }
    __syncthreads();
#define HALF_STEP(PX0, PX1, mnX, alX, PY0, PY1, alY, t, KB, VB, SB) do {                                                      \
        SBAR(); qkt<KB>(PX0, PX1, K_lds, r32, hi, S.qr);                                                         \
        finishSM(PY0, PY1, alY, l_reg, pa0, pa1, pa2, pa3); SBAR();                                                           \
        if ((t) + 1 < NT) { SLOAD_H(Kh, Vh, KBASE((t) + 1)); SBAR(); }                                               \
        pv_tile<VB>(o, vb0, pa0, pa1, pa2, pa3); MASKT(PX0, PX1, (t)); partialSM(PX0, PX1, m_reg, mnX, alX);                                        \
        __syncthreads();                                                                                                      \
        if ((t) + 1 < NT) { VMW(); SWRITE_H(SB); }                                                                          \
        RESC(alX); __syncthreads(); } while (0)
    for (int t = 1; t + 1 < NT; t += 2) {
        HALF_STEP(pB0, pB1, mnB, alB, pA0, pA1, alA, t, 1, 0, 0);
        HALF_STEP(pA0, pA1, mnA, alA, pB0, pB1, alB, t + 1, 0, 1, 1);
    }
    const bool even = (NT & 1) == 0;
    if (even) { SBAR(); qkt<1>(pB0, pB1, K_lds, r32, hi, S.qr); SBAR(); }
    { const __amdgpu_buffer_rsrc_t rQn = mkrsrc(nxt.Q), rKn = mkrsrc(nxt.K), rVn = mkrsrc(nxt.V);
      SLOAD_H(rKn, rVn, 0); SBAR();
#pragma unroll
      for (int d0 = 0; d0 < 8; ++d0) S.qr[d0] = bload(rQn, qoff + d0 * 32, 0); }
    SBAR();
    finishSM(pA0, pA1, alA, l_reg, pa0, pa1, pa2, pa3); SBAR();
    pv_tile<0>(o, vb0, pa0, pa1, pa2, pa3);
    if (even) { MASKT(pB0, pB1, NT - 1); partialSM(pB0, pB1, m_reg, mnB, alB); __syncthreads(); RESC(alB);
        finishSM(pB0, pB1, alB, l_reg, pa0, pa1, pa2, pa3); SBAR(); pv_tile<1>(o, vb0, pa0, pa1, pa2, pa3); }
    SBAR(); SEAM_K0();
    if (hi == 0) li_l[r32] = l_reg; asm volatile("s_waitcnt lgkmcnt(0)" ::: "memory");
    float rli[16];
#pragma unroll
    for (int r = 0; r < 16; ++r) rli[r] = __builtin_amdgcn_rcpf(li_l[crow(r, hi)]);
    char* Ow = (char*)(cur.O + (size_t)(wid * QBLK) * OPITCH); const unsigned ooff = (unsigned)(4 * hi * OPITCH + r32) * 4u;
#pragma unroll
    for (int r = 0; r < 16; ++r) { const int orow = (r & 3) + 8 * (r >> 2);
#pragma unroll
        for (int d0 = 0; d0 < 4; ++d0) { const float v = o[d0][r] * rli[r]; *(float*)(Ow + (size_t)(orow * OPITCH + d0 * 32) * 4 + ooff) = v; } }
    __syncthreads();
#undef RESC
#undef KBASE
#undef MASKT
#undef SEAM_K0
#undef HALF_STEP
}
#undef VMW
#undef VMWN
#undef SLOAD_H
#undef SWRITE_HK
#undef SWRITE_HV
#undef SWRITE_H
__device__ __forceinline__ bool attn_ref(int s, int vcu, int G, const bf16* proj, float* O4, int cq, int ck, int cv, BlockRef& r) {
    const int L = 2 * vcu + ((s >> 1) & 1) + (s >> 2) * 2 * G; if (L >= 512) return false;
    const int bhm = L >> 4, vh = (L >> 3) & 1, pair = L & 7, b = bhm >> 4, h = (bhm >> 1) & 7, m = bhm & 1, qb = (s & 1) ? 15 - pair : pair;
    const size_t rowb = (size_t)b * SKV;
    r.Q = proj + (rowb + (size_t)qb * QB) * PITCH + cq + h * 256 + m * 128;
    r.K = proj + rowb * PITCH + ck + h * 256 + m * 128;
    r.V = proj + rowb * PITCH + cv + h * 256 + vh * 128;
    r.O = O4 + ((size_t)m * 8192 + rowb + (size_t)qb * QB) * OPITCH + h * 256 + vh * 128;
    r.P0 = qb * QB; r.lut_off = LDS_LUT + h * LUTX * 4;
    return true;
}
__device__ __forceinline__ void attn_phase(char* lds, const bf16* proj, float* O4, const float* lutg, int vcu, int G, int cq, int ck, int cv) {
    for (int i = pg8::tidx(); i < 8 * LUTX; i += NW * 64) { const int hh = i / LUTX, d = i % LUTX - LUTX_ZERO;
        ((float*)(lds + LDS_LUT))[i] = d < 0 ? -__builtin_inff() : (d < 128 ? lutg[hh * LUT_STRIDE + d] : 0.f); }
    __syncthreads();
    BlockRef cur, nxt; int s = 0;
    if (!attn_ref(0, vcu, G, proj, O4, cq, ck, cv, cur)) return;
    Seam S;
    attn_prime(cur, lds, S);
    for (;;) {
        const bool more = attn_ref(s + 1, vcu, G, proj, O4, cq, ck, cv, nxt);
        if (!more) nxt = cur;
        attn_block(cur, nxt, lds, S);
        if (!more) break;
        cur = nxt; ++s;
    }
}
#undef KSWZ
#undef SBAR
}
namespace s5 {
typedef unsigned short bf16;
typedef short bf16x8 __attribute__((ext_vector_type(8)));
typedef short s16x4 __attribute__((ext_vector_type(4)));
typedef float f32x16 __attribute__((ext_vector_type(16)));
typedef float f32x4 __attribute__((ext_vector_type(4)));
typedef unsigned u32x2 __attribute__((ext_vector_type(2)));
constexpr int P_AB = 0, P_BF = 1024, P_CF = P_BF + 4096, P_DF = P_CF + 8192, P_BYTES = P_DF + 2048;
constexpr int IMG_ROW = 72, IMG_TILE = 32 * IMG_ROW, IMG_WAVE = 4 * IMG_TILE;
constexpr int LDS_E = 8 * IMG_WAVE, LDS_BYTES = LDS_E + 16 * 32 * 16;
constexpr int PITCH = P_IN, GP = P_DS;
__device__ __forceinline__ unsigned cvtpk(float lo, float hi) { unsigned r; asm volatile("v_cvt_pk_bf16_f32 %0, %1, %2" : "=v"(r) : "v"(lo), "v"(hi)); return r; }
__device__ __forceinline__ unsigned f2bf(float f) { unsigned u = __builtin_bit_cast(unsigned, f); return (u + 0x7fffu + ((u >> 16) & 1u)) >> 16; }
#define S5_MFMA(a, b, c) __builtin_amdgcn_mfma_f32_32x32x16_bf16((a), (b), (c), 0, 0, 0)
#define S5_SCAN16(STORE) _Pragma("unroll") for (int r = 0; r < 16; ++r) { \
        const float n0r = fmaf(a0r, h0r, fmaf(-a0i, h0i, x0[r])), n0i = fmaf(a0r, h0i, fmaf(a0i, h0r, x2[r])); \
        const float n1r = fmaf(a1r, h1r, fmaf(-a1i, h1i, x1[r])), n1i = fmaf(a1r, h1i, fmaf(a1i, h1r, x3[r])); \
        h0r = n0r; h0i = n0i; h1r = n1r; h1i = n1i; if (STORE) { x0[r] = n0r; x2[r] = n0i; x1[r] = n1r; x3[r] = n1i; } }
__device__ __forceinline__ void s5_unit(char* lds, const bf16* proj, bf16* Gout, const char* prm, int b, int g) {
    const int tid = pg8::tidx(), wid = __builtin_amdgcn_readfirstlane(tid >> 6), lane = tid & 63, j = lane & 31, h = lane >> 5;
    const f32x4 ab = *(const f32x4*)(prm + P_AB + j * 32), ap = *(const f32x4*)(prm + P_AB + j * 32 + 16);
    const float a0r = ab[0], a0i = ab[1], a1r = ab[2], a1i = ab[3];
    bf16x8 Bf[4];
#pragma unroll
    for (int n = 0; n < 4; ++n) Bf[n] = *(const bf16x8*)(prm + P_BF + (n * 64 + lane) * 16);
    const int tok0 = 512 * wid + 256 * ((j >> 2) & 1) + (j & 3) + 4 * (j >> 3);
    const bf16* up = proj + ((size_t)b * 4096 + tok0) * PITCH + g * 16 + 8 * h;
    const f32x16 zero = {};
    f32x4* E = (f32x4*)(lds + LDS_E);
    float h0r = 0.f, h0i = 0.f, h1r = 0.f, h1i = 0.f;
    {
        bf16x8 ub[4];
#pragma unroll
        for (int i = 0; i < 4; ++i) ub[i] = *(const bf16x8*)(up + (size_t)(i * 16) * PITCH);
        for (int k0 = 0; k0 < 16; k0 += 4) {
#pragma unroll
            for (int kk = 0; kk < 4; ++kk) {
                const bf16x8 uf = ub[kk]; { const int kn = k0 + kk + 4; ub[kk] = *(const bf16x8*)(up + (size_t)((kn < 16 ? kn : 15) * 16) * PITCH); }
                f32x16 x0 = S5_MFMA(uf, Bf[0], zero), x1 = S5_MFMA(uf, Bf[1], zero), x2 = S5_MFMA(uf, Bf[2], zero), x3 = S5_MFMA(uf, Bf[3], zero);
                S5_SCAN16(false)
            }
        }
    }
    E[(2 * wid + h) * 32 + j] = (f32x4){h0r, h0i, h1r, h1i};
    __syncthreads();
    h0r = 0.f; h0i = 0.f; h1r = 0.f; h1i = 0.f;
    {
        const int chunk = 2 * wid + h;
        for (int c = 0; c < 2 * wid + 1; ++c) {
            const f32x4 e = E[c * 32 + j];
            const float n0r = fmaf(ap[0], h0r, fmaf(-ap[1], h0i, e[0])), n0i = fmaf(ap[0], h0i, fmaf(ap[1], h0r, e[1]));
            const float n1r = fmaf(ap[2], h1r, fmaf(-ap[3], h1i, e[2])), n1i = fmaf(ap[2], h1i, fmaf(ap[3], h1r, e[3]));
            if (c < chunk) { h0r = n0r; h0i = n0i; h1r = n1r; h1i = n1i; }
        }
    }
    bf16x8 Cf[4][2], Df[2];
#pragma unroll
    for (int n = 0; n < 4; ++n)
#pragma unroll
        for (int s = 0; s < 2; ++s) Cf[n][s] = *(const bf16x8*)(prm + P_CF + ((n * 2 + s) * 64 + lane) * 16);
    Df[0] = *(const bf16x8*)(prm + P_DF + lane * 16); Df[1] = *(const bf16x8*)(prm + P_DF + (64 + lane) * 16);
    char* img = lds + wid * IMG_WAVE;
    char* stp = img + j * IMG_ROW + 8 * h;
    const int i16 = lane & 15, q = i16 >> 2, p = i16 & 3, blk = (lane >> 4) & 1;
    const unsigned trb = (unsigned)(uintptr_t)img + (8 * h + q) * IMG_ROW + 8 * (4 * blk + p);
    bf16* gp = Gout + ((size_t)b * 4096 + 512 * wid + 256 * h) * GP + g * 16 + j;
    {
        bf16x8 ub[4];
#pragma unroll
        for (int i = 0; i < 4; ++i) ub[i] = *(const bf16x8*)(up + (size_t)(i * 16) * PITCH);
        for (int k0 = 0; k0 < 16; k0 += 4) {
#pragma unroll
          for (int kk = 0; kk < 4; ++kk) {
            const int k = k0 + kk;
            const bf16x8 uf = ub[kk]; { const int kn = k + 4; ub[kk] = *(const bf16x8*)(up + (size_t)((kn < 16 ? kn : 15) * 16) * PITCH); }
            f32x16 x0 = S5_MFMA(uf, Bf[0], zero), x1 = S5_MFMA(uf, Bf[1], zero), x2 = S5_MFMA(uf, Bf[2], zero), x3 = S5_MFMA(uf, Bf[3], zero);
            S5_SCAN16(true)
#define S5_IMG(X, n) _Pragma("unroll") for (int g4 = 0; g4 < 4; ++g4) { u32x2 w; w.x = cvtpk(X[4 * g4], X[4 * g4 + 1]); w.y = cvtpk(X[4 * g4 + 2], X[4 * g4 + 3]); *(u32x2*)(stp + (n) * IMG_TILE + 16 * g4) = w; }
            S5_IMG(x0, 0) S5_IMG(x1, 1) S5_IMG(x2, 2) S5_IMG(x3, 3)
#undef S5_IMG
            asm volatile("s_waitcnt lgkmcnt(0)" ::: "memory"); __builtin_amdgcn_sched_barrier(0);
            f32x16 y = zero;
#define S5_TR(dst, off) asm volatile("ds_read_b64_tr_b16 %0, %1 offset:%2" : "=&v"(dst) : "v"(trb), "i"(off) : "memory")
#define S5_YN(n) do { s16x4 l0, q0, l1, q1; S5_TR(l0, (n) * IMG_TILE); S5_TR(q0, (n) * IMG_TILE + 4 * IMG_ROW); S5_TR(l1, (n) * IMG_TILE + 16 * IMG_ROW); S5_TR(q1, (n) * IMG_TILE + 20 * IMG_ROW); \
            asm volatile("s_waitcnt lgkmcnt(0)" ::: "memory"); __builtin_amdgcn_sched_barrier(0); \
            y = S5_MFMA(((bf16x8){l0[0], l0[1], l0[2], l0[3], q0[0], q0[1], q0[2], q0[3]}), Cf[n][0], y); \
            y = S5_MFMA(((bf16x8){l1[0], l1[1], l1[2], l1[3], q1[0], q1[1], q1[2], q1[3]}), Cf[n][1], y); } while (0)
            S5_YN(0); S5_YN(1); S5_YN(2); S5_YN(3);
#undef S5_YN
#undef S5_TR
            y = S5_MFMA(uf, Df[0], y); y = S5_MFMA(uf, Df[1], y);
#pragma unroll
            for (int i = 0; i < 16; ++i) {
                const float v = y[i], t = 1.5957691216057308f * (v + 0.044715f * v * v * v);
                const float gl = v * __builtin_amdgcn_rcpf(1.0f + __builtin_amdgcn_exp2f(-1.4426950408889634f * t));
                if (j < 16) gp[(size_t)(16 * k + i) * GP] = (bf16)f2bf(gl);
            }
          }
        }
    }
    __syncthreads();
}
#undef S5_MFMA
#undef S5_SCAN16
}
constexpr int NWAVES = 8;
#ifndef MK_SPLIT
#define MK_SPLIT 0
#endif
constexpr int N_PHASES = 15;

constexpr int BATCH = 2, SEQ = 4096, DM = 4096, M = BATCH * SEQ, DSSM = 2048, DATT = 2048, NIN = 20480, NHEAD = 8, NGRP = 128, DEPTH = 2;
constexpr int C_US = 0, C_ZS = 2048, C_Q = 4096, C_K = 6144, C_V = 8192, C_ZA = 10240, C_GS = 12288, C_GA = 16384;
constexpr float EPS = 1e-6f, SUBLN_EPS = 1e-5f;
enum { I_X = 0, I_C, I_NORMG, I_WADA, I_BADA, I_WIN, I_LRE, I_LIM, I_LDT, I_BRE, I_BIM, I_CRE, I_CIM, I_SD, I_WGLU, I_LQ1, I_LK1, I_LQ2, I_LK2, I_SUBG, I_WOS, I_WOA, I_WO, I_RELB, I_FING, N_INPUTS };

constexpr size_t MiB = 1u << 20;
constexpr size_t WS_CTL = 0, CTL_ZERO_BYTES = 1 * MiB;
constexpr size_t WS_MODP = 1 * MiB;
constexpr size_t WS_MOD = 4 * MiB;
constexpr size_t WS_LUT = 4 * MiB + 256 * 1024;
constexpr size_t WS_S5P = 5 * MiB;
constexpr size_t WS_WT = 16 * MiB;
constexpr size_t WT_IN = 0, WT_GLU = 164 * MiB, WT_OS = 173 * MiB, WT_OA = 190 * MiB, WT_O = 207 * MiB, WT_LAYER = 240 * MiB;
constexpr size_t WS_HMOD = 496 * MiB;
constexpr size_t WS_PROJ = 562 * MiB;
constexpr size_t WS_G = 884 * MiB;
constexpr size_t WS_YS = 918 * MiB;
constexpr size_t WS_O4 = 952 * MiB;
constexpr size_t WS_YA = 1084 * MiB;
constexpr size_t WS_T = 1118 * MiB;
constexpr size_t WS_MRG = 1184 * MiB;
constexpr size_t WS_H1 = 1250 * MiB;
constexpr size_t WS_END = 1380 * MiB;
static_assert(WS_WT + 2 * WT_LAYER <= WS_HMOD && WS_S5P + 2 * 128 * 15360 <= WS_WT && WS_MODP + 2 * 16 * 2 * 12288 * 4 <= WS_MOD, "d_ws map");
static_assert((size_t)NIN * P_DM * 2 <= WT_GLU && WT_GLU + (size_t)DSSM * P_DS * 2 <= WT_OS && WT_OS + (size_t)DM * P_DS * 2 <= WT_OA && WT_OA + (size_t)DM * P_DS * 2 <= WT_O && WT_O + (size_t)DM * P_DM * 2 <= WT_LAYER, "weight map");
static_assert(WS_HMOD + (size_t)M * P_DM * 2 <= WS_PROJ && WS_PROJ + (size_t)M * P_IN * 2 <= WS_G && WS_G + (size_t)M * P_DS * 2 <= WS_YS && WS_YS + (size_t)M * P_DS * 2 <= WS_O4 && WS_O4 + (size_t)2 * M * P_O4 * 4 <= WS_YA
              && WS_YA + (size_t)M * P_DS * 2 <= WS_T && WS_T + (size_t)M * P_DM * 2 <= WS_MRG && WS_MRG + (size_t)M * P_DM * 2 <= WS_H1 && WS_H1 + (size_t)M * P_H1 * 4 <= WS_END, "activation map");
constexpr int CW_TMO = 0, CW_CODE = 1;
constexpr int CW_BAR = 4096;

constexpr int RING_OFF = 0, RING_BYTES = 139264;
constexpr int LDSCTL_OFF = RING_BYTES, MISC_OFF = LDSCTL_OFF + 320;
constexpr int LDS_BYTES = 147456;
static_assert(MISC_OFF + 128 <= LDS_BYTES && att::LDS_BYTES <= RING_BYTES && s5::LDS_BYTES <= RING_BYTES && pg8::STAGE_BYTES <= RING_BYTES, "LDS map");
#define GAS __attribute__((address_space(1)))
#define LAS __attribute__((address_space(3)))
typedef unsigned short bf16;
typedef unsigned v4u __attribute__((ext_vector_type(4)));
typedef float f32x4 __attribute__((ext_vector_type(4)));
typedef short bf16x8 __attribute__((ext_vector_type(8)));
typedef GAS unsigned gu32;
typedef GAS unsigned long long gu64;
#define RLX_AGENT __ATOMIC_RELAXED, __HIP_MEMORY_SCOPE_AGENT
#define LDS_WAIT() asm volatile("s_waitcnt lgkmcnt(0)" ::: "memory")
#define VM_WAIT() asm volatile("s_waitcnt vmcnt(0)" ::: "memory")
__device__ __forceinline__ unsigned long long rt() { return __builtin_amdgcn_s_memrealtime(); }
__device__ __forceinline__ unsigned f2bf(float f) { unsigned u = __builtin_bit_cast(unsigned, f); return (u + 0x7fffu + ((u >> 16) & 1u)) >> 16; }
__device__ __forceinline__ unsigned pk2(float lo, float hi) { return f2bf(lo) | (f2bf(hi) << 16); }
#define XB_TMO      128
#define XB_XCNT(j)  (256  + 64 * (j))
#define XB_XSUB(j)  (1280 + 64 * (j))
#define XB_XGEN(j)  (2304 + 64 * (j))
#define XB_TOP      3328
#define XB_TOPGEN   3392
#define XCD_BAR_WORDS 3456
#define XB_SPIN_CAP (1u << 18)

__device__ __forceinline__ unsigned xb_ld(unsigned* p)              { return __hip_atomic_load(p, __ATOMIC_RELAXED, __HIP_MEMORY_SCOPE_AGENT); }
__device__ __forceinline__ unsigned xb_add(unsigned* p, unsigned v) { return __hip_atomic_fetch_add(p, v, __ATOMIC_RELAXED, __HIP_MEMORY_SCOPE_AGENT); }
__device__ __forceinline__ unsigned xb_xcc_id() { return (unsigned)__builtin_amdgcn_s_getreg((3 << 11) | 20) & 0xFu; }
#define XB_SPIN(cond, bar) do { unsigned _sp = 0; while (cond) { __builtin_amdgcn_s_sleep(1); \
    if ((++_sp & 255u) == 0u) { if (xb_ld(&(bar)[XB_TMO])) break; if (_sp > XB_SPIN_CAP) { atomicAdd(&(bar)[XB_TMO], 1u); break; } } } } while (0)

struct XcdBarrier {
    unsigned* bar; unsigned x;
    volatile LAS unsigned* st;
};

__device__ __forceinline__ XcdBarrier xcd_barrier_post(unsigned* bar, volatile LAS unsigned* st) {
    XcdBarrier b; b.bar = bar; b.x = xb_xcc_id(); b.st = st;
    if (threadIdx.x == 0) (void)xb_add(&bar[XB_XCNT(b.x)], 1u);
    return b;
}
__device__ __forceinline__ void xcd_barrier_complete(unsigned* bar, unsigned x, unsigned& nloc, unsigned& nx) {
    const unsigned G = gridDim.x * gridDim.y * gridDim.z;
    unsigned sum, cnt, mine, sp = 0u;
    for (;;) {
        sum = 0u; cnt = 0u; mine = 0u;
#pragma unroll
        for (unsigned j = 0; j < 16; ++j) { const unsigned c = xb_ld(&bar[XB_XCNT(j)]); sum += c; cnt += (c > 0u) ? 1u : 0u; mine = (j == x) ? c : mine; }
        if (sum == G) break;
        __builtin_amdgcn_s_sleep(1);
        if ((++sp & 255u) == 0u) { if (xb_ld(&bar[XB_TMO])) break; if (sp > XB_SPIN_CAP) { atomicAdd(&bar[XB_TMO], 1u); break; } }
    }
    nloc = mine > 0u ? mine : 1u; nx = cnt > 0u ? cnt : 1u;
}

__device__ __forceinline__ void xcd_barrier(const XcdBarrier& b) {
    asm volatile("s_waitcnt vmcnt(0)" ::: "memory");
    __syncthreads();
    if (threadIdx.x == 0) {
        unsigned* bar = b.bar;
        __builtin_amdgcn_s_waitcnt(0);
        unsigned nloc = b.st[0], nx = b.st[1];
        if (nloc == 0u) { xcd_barrier_complete(bar, b.x, nloc, nx); b.st[0] = nloc; b.st[1] = nx; }
        const unsigned old = xb_add(&bar[XB_XSUB(b.x)], 1u);
        const unsigned gen = old / nloc;
        if (old + 1u == (gen + 1u) * nloc) {
            __builtin_amdgcn_fence(__ATOMIC_RELEASE, "agent");
            asm volatile("s_waitcnt vmcnt(0)" ::: "memory");
            const unsigned og = xb_add(&bar[XB_TOP], 1u);
            const unsigned tg = og / nx;
            if (og + 1u == (tg + 1u) * nx) xb_add(&bar[XB_TOPGEN], 1u);
            else XB_SPIN(xb_ld(&bar[XB_TOPGEN]) == tg, bar);
            __builtin_amdgcn_fence(__ATOMIC_ACQUIRE, "agent");
            xb_add(&bar[XB_XGEN(b.x)], 1u);
            asm volatile("s_waitcnt vmcnt(0)" ::: "memory");
        } else {
            XB_SPIN(xb_ld(&bar[XB_XGEN(b.x)]) == gen, bar);
            __builtin_amdgcn_fence(__ATOMIC_ACQUIRE, "agent");
            asm volatile("s_waitcnt vmcnt(0)" ::: "memory");
        }
    }
    __syncthreads();
}
struct Frame {
    LAS unsigned char* lds;
    volatile LAS unsigned* MISC;
    gu32* ctl;
    int tid, lane, wave;
    int vcu, G;
    unsigned char* ws;
};
__device__ __forceinline__ float wave_sum(float v) {
#pragma unroll
    for (int o = 1; o < 64; o <<= 1) v += __shfl_xor(v, o);
    return v;
}
__device__ __forceinline__ float sigmoid_f(float x) { return __builtin_amdgcn_rcpf(1.0f + __builtin_amdgcn_exp2f(-1.4426950408889634f * x)); }
__device__ __forceinline__ float bflo(unsigned w) { return __uint_as_float(w << 16); }
__device__ __forceinline__ float bfhi(unsigned w) { return __uint_as_float(w & 0xffff0000u); }

__device__ __forceinline__ void p0_transpose_item(const float* W, int K, int N, bf16* WT, int ldw, LAS float* scr, int item, int lane) {
    const int nblk = N / 64, kb = item / nblk, nb = item % nblk, k0 = 64 * kb, n0 = 64 * nb;
    const int kl = lane >> 4, nq = lane & 15;
    f32x4 v[16];
#pragma unroll
    for (int i = 0; i < 16; ++i) v[i] = *(const GAS f32x4*)(W + (size_t)(k0 + 4 * i + kl) * N + n0 + 4 * nq);
#pragma unroll
    for (int i = 0; i < 16; ++i) { LAS float* s = scr + (4 * i + kl) * 65 + 4 * nq; s[0] = v[i].x; s[1] = v[i].y; s[2] = v[i].z; s[3] = v[i].w; }
    LDS_WAIT(); asm volatile("" ::: "memory");
    const int c = lane & 7;
#pragma unroll
    for (int j = 0; j < 8; ++j) { const int n = (lane >> 3) + 8 * j; const LAS float* s = scr + (8 * c) * 65 + n;
        v4u o; o.x = pk2(s[0 * 65], s[1 * 65]); o.y = pk2(s[2 * 65], s[3 * 65]); o.z = pk2(s[4 * 65], s[5 * 65]); o.w = pk2(s[6 * 65], s[7 * 65]);
        *(GAS v4u*)(WT + (size_t)(n0 + n) * ldw + k0 + 8 * c) = o; }
    LDS_WAIT(); asm volatile("" ::: "memory");
}
__device__ __forceinline__ void p0_gemv_item(const float* Wl, const float* cvec, float* part, int cc, int ks, int lane) {
    f32x4 c0 = *(const GAS f32x4*)(cvec + 256 * ks + 4 * lane), c1 = *(const GAS f32x4*)(cvec + DM + 256 * ks + 4 * lane);
#pragma unroll
    for (int e = 0; e < 4; ++e) { c0[e] = c0[e] * sigmoid_f(c0[e]); c1[e] = c1[e] * sigmoid_f(c1[e]); }
    f32x4 a0 = {0.f, 0.f, 0.f, 0.f}, a1 = {0.f, 0.f, 0.f, 0.f};
    const float* wp = Wl + (size_t)(256 * ks) * 12288 + 256 * cc + 4 * lane;
    for (int s = 0; s < 64; s += 4) {
        f32x4 w[16];
#pragma unroll
        for (int i = 0; i < 16; ++i) w[i] = *(const GAS f32x4*)(wp + (size_t)(4 * s + i) * 12288);
#pragma unroll
        for (int i = 0; i < 16; ++i) { const int sl = s + (i >> 2), e = i & 3;
            const float ca = __uint_as_float(__builtin_amdgcn_readlane(__float_as_uint(c0[e]), sl)), cb = __uint_as_float(__builtin_amdgcn_readlane(__float_as_uint(c1[e]), sl));
            a0 = a0 + w[i] * ca; a1 = a1 + w[i] * cb; }
    }
    *(GAS f32x4*)(part + ((size_t)ks * 2 + 0) * 12288 + 256 * cc + 4 * lane) = a0;
    *(GAS f32x4*)(part + ((size_t)ks * 2 + 1) * 12288 + 256 * cc + 4 * lane) = a1;
}
__device__ __forceinline__ void sincos_d(double x, double& s, double& c) {
    const double kq = __builtin_rint(x * 0.63661977236758134308);
    double r = __builtin_fma(-kq, 1.57079632679489655800e+00, x); r = __builtin_fma(-kq, 6.12323399573676603587e-17, r);
    const double r2 = r * r;
    double ps = -1.0 / 355687428096000.0; ps = ps * r2 + 1.0 / 1307674368000.0; ps = ps * r2 - 1.0 / 6227020800.0; ps = ps * r2 + 1.0 / 39916800.0; ps = ps * r2 - 1.0 / 362880.0;
    ps = ps * r2 + 1.0 / 5040.0; ps = ps * r2 - 1.0 / 120.0; ps = ps * r2 + 1.0 / 6.0; ps = ps * r2 * (-r) + r;
    double pc = 1.0 / 20922789888000.0; pc = pc * r2 - 1.0 / 87178291200.0; pc = pc * r2 + 1.0 / 479001600.0; pc = pc * r2 - 1.0 / 3628800.0; pc = pc * r2 + 1.0 / 40320.0;
    pc = pc * r2 - 1.0 / 720.0; pc = pc * r2 + 1.0 / 24.0; pc = pc * r2 - 0.5; pc = pc * r2 + 1.0;
    const int qd = ((int)kq) & 3;
    s = (qd == 0) ? ps : (qd == 1) ? pc : (qd == 2) ? -ps : -pc;
    c = (qd == 0) ? pc : (qd == 1) ? -ps : (qd == 2) ? -pc : ps;
}
__device__ __forceinline__ double exp_small_d(double y) {
    double p = 1.0 / 3628800.0; p = p * y + 1.0 / 362880.0; p = p * y + 1.0 / 40320.0; p = p * y + 1.0 / 5040.0; p = p * y + 1.0 / 720.0; p = p * y + 1.0 / 120.0;
    p = p * y + 1.0 / 24.0; p = p * y + 1.0 / 6.0; p = p * y + 0.5; p = p * y + 1.0; p = p * y + 1.0; return p;
}
__device__ __forceinline__ void p0_s5_params(const float* const* in, unsigned char* ws, int idx) {
    const int l = idx >> 13, g = (idx >> 6) & 127, p = idx & 63, lg = l * NGRP + g;
    unsigned char* prm = ws + WS_S5P + (size_t)lg * s5::P_BYTES;
    const double lr = (double)in[I_LRE][lg * 64 + p], li = (double)in[I_LIM][lg * 64 + p];
    const double dt = (double)expf(in[I_LDT][lg]);
    const double mag = exp_small_d(lr * dt); double sn, cs; sincos_d(li * dt, sn, cs);
    const double are = mag * cs, aim = mag * sn;
    const double den = lr * lr + li * li, nre = are - 1.0;
    const double cre = (nre * lr + aim * li) / den, cim = (aim * lr - nre * li) / den;
    double pr = are, pi = aim;
#pragma unroll
    for (int i = 0; i < 8; ++i) { const double t = pr * pr - pi * pi; pi = 2.0 * pr * pi; pr = t; }
    { float* ab = (float*)(prm + s5::P_AB) + (p & 31) * 8 + (p >> 5) * 2; ab[0] = (float)are; ab[1] = (float)aim; ab[4] = (float)pr; ab[5] = (float)pi; }
    bf16* BF = (bf16*)(prm + s5::P_BF); bf16* CF = (bf16*)(prm + s5::P_CF); bf16* DF = (bf16*)(prm + s5::P_DF);
    const float* bre = in[I_BRE] + ((size_t)lg * 64 + p) * 16; const float* bim = in[I_BIM] + ((size_t)lg * 64 + p) * 16;
    const float* cr = in[I_CRE] + (size_t)lg * 16 * 64 + p; const float* ci = in[I_CIM] + (size_t)lg * 16 * 64 + p;
#pragma unroll
    for (int c = 0; c < 16; ++c) {
        const double br = (double)bre[c], bi = (double)bim[c];
        const float bbr = (float)(cre * br - cim * bi), bbi = (float)(cre * bi + cim * br);
        const int kg = c >> 3, e = c & 7;
        { const int pp = p;      BF[(((pp >> 5) * 64) + kg * 32 + (pp & 31)) * 8 + e] = (bf16)f2bf(bbr); }
        { const int pp = 64 + p; BF[(((pp >> 5) * 64) + kg * 32 + (pp & 31)) * 8 + e] = (bf16)f2bf(bbi); }
    }
#pragma unroll
    for (int c = 0; c < 32; ++c) {
        const float vr = c < 16 ? cr[(c & 15) * 64] : 0.f, vi = c < 16 ? -ci[(c & 15) * 64] : 0.f;
        { const int pp = p;      CF[((((pp >> 5) * 2 + ((pp >> 4) & 1)) * 64) + ((pp >> 3) & 1) * 32 + c) * 8 + (pp & 7)] = (bf16)f2bf(vr); }
        { const int pp = 64 + p; CF[((((pp >> 5) * 2 + ((pp >> 4) & 1)) * 64) + ((pp >> 3) & 1) * 32 + c) * 8 + (pp & 7)] = (bf16)f2bf(vi); }
    }
    {
        const int c = p & 31, kg = p >> 5;
#pragma unroll
        for (int e = 0; e < 8; ++e) { const int k = 8 * kg + e; float dv = (k == c && c < 16) ? in[I_SD][lg * 16 + (c & 15)] : 0.f;
            const unsigned hb = f2bf(dv); const float lo = dv - __uint_as_float(hb << 16);
            DF[p * 8 + e] = (bf16)hb; DF[(64 + p) * 8 + e] = (bf16)f2bf(lo); }
    }
}
__device__ __forceinline__ void p0_prologue(Frame& F, const float* const* in) {
    LAS float* scr = (LAS float*)(F.lds + RING_OFF + F.wave * 16640);
    const int gw = F.vcu * NWAVES + F.wave, NGW = F.G * NWAVES;
    constexpr int T_IN = (DM / 64) * (NIN / 64), T_GLU = (DSSM / 64) * (DSSM / 64), T_OS = (DSSM / 64) * (DM / 64), T_OA = (DATT / 64) * (DM / 64), T_O = (DM / 64) * (DM / 64);
    constexpr int T_LAYER = T_IN + T_GLU + T_OS + T_OA + T_O, N_GEMV = DEPTH * 48 * 16, N_S5 = DEPTH * NGRP, N_ITEMS = DEPTH * T_LAYER + N_GEMV + N_S5 + 1;
    for (int it = gw; it < N_ITEMS; it += NGW) {
        int r = it;
        if (r < DEPTH * T_LAYER) {
            const int l = r / T_LAYER; r -= l * T_LAYER; bf16* wt = (bf16*)(F.ws + WS_WT + (size_t)l * WT_LAYER);
            if (r < T_IN) { p0_transpose_item(in[I_WIN] + (size_t)l * DM * NIN, DM, NIN, wt + WT_IN / 2, P_DM, scr, r, F.lane); continue; } r -= T_IN;
            if (r < T_GLU) { p0_transpose_item(in[I_WGLU] + (size_t)l * DSSM * DSSM, DSSM, DSSM, wt + WT_GLU / 2, P_DS, scr, r, F.lane); continue; } r -= T_GLU;
            if (r < T_OS) { p0_transpose_item(in[I_WOS] + (size_t)l * DSSM * DM, DSSM, DM, wt + WT_OS / 2, P_DS, scr, r, F.lane); continue; } r -= T_OS;
            if (r < T_OA) { p0_transpose_item(in[I_WOA] + (size_t)l * DATT * DM, DATT, DM, wt + WT_OA / 2, P_DS, scr, r, F.lane); continue; } r -= T_OA;
            p0_transpose_item(in[I_WO] + (size_t)l * DM * DM, DM, DM, wt + WT_O / 2, P_DM, scr, r, F.lane); continue;
        }
        r -= DEPTH * T_LAYER;
        if (r < N_GEMV) { const int l = r / (48 * 16), q = r % (48 * 16);
            p0_gemv_item(in[I_WADA] + (size_t)l * DM * 12288, in[I_C], (float*)(F.ws + WS_MODP) + (size_t)l * 16 * 2 * 12288, q % 48, q / 48, F.lane); continue; }
        r -= N_GEMV;
        if (r < N_S5) { p0_s5_params(in, F.ws, r * 64 + F.lane); continue; }
        {
            float* lut = (float*)(F.ws + WS_LUT);
            for (int i = F.lane; i < 8 * att::LUT_STRIDE; i += 64) { const int hh = i / att::LUT_STRIDE, d = i % att::LUT_STRIDE; float v = 0.f;
                if (d < 128) { int bk = d; if (d >= 16) { bk = 16 + (int)(logf((float)d / 16.0f) / 2.0794415416798357f * 16.0f); bk = bk > 31 ? 31 : bk; }
                    v = (in[I_RELB][bk * 8 + hh] - in[I_RELB][31 * 8 + hh]) * 11.313708498984761f; }
                lut[i] = v; }
        }
    }
}
__device__ __forceinline__ void p1_mod_finalize(Frame& F, const float* const* in) {
    const int t = F.vcu * (NWAVES * 64) + F.tid;
    if (t < DEPTH * BATCH * 12288) { const int l = t / (BATCH * 12288), r = t % (BATCH * 12288), b = r / 12288, j = r % 12288;
        const float* part = (const float*)(F.ws + WS_MODP) + (size_t)l * 16 * 2 * 12288 + (size_t)b * 12288 + j; float s = in[I_BADA][l * 12288 + j];
#pragma unroll
        for (int k = 0; k < 16; ++k) s += part[(size_t)k * 2 * 12288];
        ((float*)(F.ws + WS_MOD))[t] = s; }
}
__device__ __forceinline__ void pa_norm(Frame& F, const float* x, int ldx, const float* g, const float* mod  , bf16* out) {
    const int gw = F.vcu * NWAVES + F.wave, NGW = F.G * NWAVES;
    for (int m = gw; m < M; m += NGW) {
        const GAS f32x4* xr = (const GAS f32x4*)(x + (size_t)m * ldx) + F.lane;
        f32x4 v[16]; float s = 0.f;
#pragma unroll
        for (int j = 0; j < 16; ++j) { v[j] = xr[64 * j]; s += (v[j].x * v[j].x + v[j].y * v[j].y) + (v[j].z * v[j].z + v[j].w * v[j].w); }
        const float rstd = 1.0f / sqrtf(wave_sum(s) * (1.0f / DM) + EPS);
        const float* mb = mod + (size_t)(m / SEQ) * 12288;
        GAS unsigned long long* o8 = (GAS unsigned long long*)(out + (size_t)m * P_DM) + F.lane;
#pragma unroll
        for (int j = 0; j < 16; ++j) { const int col = 4 * (F.lane + 64 * j);
            const f32x4 gv = *(const GAS f32x4*)(g + col), sh = *(const GAS f32x4*)(mb + col), sc = *(const GAS f32x4*)(mb + DM + col);
            const f32x4 o = v[j] * rstd * gv * (sc + 1.0f) + sh;
            o8[64 * j] = (unsigned long long)pk2(o.x, o.y) | ((unsigned long long)pk2(o.z, o.w) << 32); }
    }
}
__device__ __forceinline__ void pz_final(Frame& F, float* h, const float* g) {
    const int gw = F.vcu * NWAVES + F.wave, NGW = F.G * NWAVES;
    for (int m = gw; m < M; m += NGW) {
        GAS f32x4* xr = (GAS f32x4*)(h + (size_t)m * DM) + F.lane;
        f32x4 v[16]; float s = 0.f;
#pragma unroll
        for (int j = 0; j < 16; ++j) { v[j] = xr[64 * j]; s += (v[j].x * v[j].x + v[j].y * v[j].y) + (v[j].z * v[j].z + v[j].w * v[j].w); }
        const float rstd = 1.0f / sqrtf(wave_sum(s) * (1.0f / DM) + EPS);
#pragma unroll
        for (int j = 0; j < 16; ++j) { const f32x4 gv = *(const GAS f32x4*)(g + 4 * (F.lane + 64 * j)); xr[64 * j] = v[j] * rstd * gv; }
    }
}
__device__ __forceinline__ void pd_combine(Frame& F, const float* O4, const bf16* proj, const float* const* in, int l, bf16* ya) {
    const float lam_init = (l == 0) ? 0.2f : 0.35550906759096926f;
    float d1 = 0.f, d2 = 0.f;
    { const float* q1 = in[I_LQ1] + l * 128; const float* k1 = in[I_LK1] + l * 128; const float* q2 = in[I_LQ2] + l * 128; const float* k2 = in[I_LK2] + l * 128;
      d1 = q1[F.lane] * k1[F.lane] + q1[F.lane + 64] * k1[F.lane + 64]; d2 = q2[F.lane] * k2[F.lane] + q2[F.lane + 64] * k2[F.lane + 64]; }
    const float lam = expf(wave_sum(d1)) - expf(wave_sum(d2)) + lam_init;
    const f32x4 sg = *(const GAS f32x4*)(in[I_SUBG] + l * 256 + 4 * F.lane) * (1.0f - lam_init);
    const int gw = F.vcu * NWAVES + F.wave, NGW = F.G * NWAVES;
    for (int it0 = 4 * gw; it0 < M * NHEAD; it0 += 4 * NGW) {
        f32x4 o0[4], o1[4]; unsigned long long zz[4];
#pragma unroll
        for (int q = 0; q < 4; ++q) { const int it = it0 + q, m = it >> 3, hh = it & 7; const size_t off = (size_t)m * P_O4 + hh * 256 + 4 * F.lane;
            o0[q] = *(const GAS f32x4*)(O4 + off); o1[q] = *(const GAS f32x4*)(O4 + (size_t)M * P_O4 + off);
            zz[q] = *(const GAS unsigned long long*)(proj + (size_t)m * P_IN + C_ZA + hh * 256 + 4 * F.lane); }
#pragma unroll
        for (int q = 0; q < 4; ++q) { const int it = it0 + q, m = it >> 3, hh = it & 7;
            const f32x4 d = o0[q] - o1[q] * lam;
            const float rstd = 1.0f / sqrtf(wave_sum((d.x * d.x + d.y * d.y) + (d.z * d.z + d.w * d.w)) * (1.0f / 256.0f) + SUBLN_EPS);
            const unsigned zl = (unsigned)zz[q], zh = (unsigned)(zz[q] >> 32);
            f32x4 z = {bflo(zl), bfhi(zl), bflo(zh), bfhi(zh)};
#pragma unroll
            for (int e = 0; e < 4; ++e) z[e] = z[e] * sigmoid_f(z[e]);
            const f32x4 o = d * rstd * sg * z;
            *(GAS unsigned long long*)(ya + (size_t)m * P_DS + hh * 256 + 4 * F.lane) = (unsigned long long)pk2(o.x, o.y) | ((unsigned long long)pk2(o.z, o.w) << 32); }
    }
}
template <class T> __device__ __forceinline__ T* opq(T* p) { GAS T* g = (GAS T*)p; asm volatile("" : "+s"(g)); return (T*)g; }
struct Args { const float* in[N_INPUTS]; float* out; unsigned char* ws; int ph_lo, ph_hi; };
__global__ void __launch_bounds__(NWAVES * 64, 2) hybrid_fwd(Args args) {
    extern __shared__ __attribute__((aligned(16))) unsigned char lds[];
    Frame F;
    F.lds = (LAS unsigned char*)lds;
    F.MISC = (volatile LAS unsigned*)(F.lds + MISC_OFF);
    F.tid = threadIdx.x; F.lane = F.tid & 63; F.wave = __builtin_amdgcn_readfirstlane(F.tid >> 6);
    F.G = gridDim.x; { const int bx = blockIdx.x; F.vcu = (F.G % 8 == 0) ? (bx % 8) * (F.G / 8) + bx / 8 : bx; }
    F.ws = args.ws; F.ctl = (gu32*)(args.ws + WS_CTL);
    const float* const* in = args.in;
    for (int u = F.tid; u < (LDS_BYTES - LDSCTL_OFF) / 4; u += NWAVES * 64) ((LAS unsigned*)(F.lds + LDSCTL_OFF))[u] = 0u;
    __syncthreads();
    XcdBarrier bar; bar.bar = (unsigned*)(F.ctl + CW_BAR); bar.x = 0; bar.st = nullptr;
    if (!MK_SPLIT) bar = xcd_barrier_post((unsigned*)(F.ctl + CW_BAR), F.MISC + 8);
#define GRID_BAR(seam) do { if (MK_SPLIT) { if (F.tid == 0) __hip_atomic_store(F.ctl + CW_TMO, 0xBADBA0u | (unsigned)(seam), RLX_AGENT); } else { xcd_barrier(bar); } } while (0)
    const int lo = args.ph_lo, hi = args.ph_hi;
#define IN(k) (lo <= (k) && (k) < hi)
#ifndef PHMASK
#define PHMASK 0xFFFF
#endif
#define PHM(k) ((PHMASK >> (k)) & 1)
#ifndef REPMASK
#define REPMASK 0
#endif
#define REP(k) for (int rep_ = 0; rep_ < 1 + ((REPMASK >> (k)) & 1); ++rep_)
#define BOTH(k) (IN(k) && IN((k) + 1))
#define WSP(T, off) ((T*)(opq(args.ws) + (off)))
#define FRESH() do { F.tid = pg8::tidx(); F.lane = F.tid & 63; F.wave = __builtin_amdgcn_readfirstlane(F.tid >> 6); } while (0)
#define INP(i) (opq(args.in[i]))

    REP(0) if (PHM(0) && IN(0)) { FRESH(); p0_prologue(F, in); if (BOTH(0)) GRID_BAR(0); }
    if (PHM(1) && IN(1)) { FRESH(); p1_mod_finalize(F, in); if (BOTH(1)) GRID_BAR(1); }

    for (int l = 0; l < DEPTH; ++l) {
        const int pb = 2 + 6 * l;
        REP(2) if (PHM(2) && IN(pb)) { FRESH(); pa_norm(F, (l == 0) ? INP(I_X) : WSP(const float, WS_H1), (l == 0) ? DM : P_H1, INP(I_NORMG) + l * DM, WSP(const float, WS_MOD) + (size_t)l * BATCH * 12288, WSP(bf16, WS_HMOD)); if (BOTH(pb)) GRID_BAR(pb); }
        REP(3) if (PHM(3) && IN(pb + 1)) {
            pg8::Gemm g{WSP(const bf16, WS_HMOD), WSP(const bf16, WS_WT + (size_t)l * WT_LAYER + WT_IN), M, NIN, DM, P_DM, P_DM}; pg8::StaticOrder S; S.init(M, NIN, F.G, (int)blockIdx.x);
            pg8::EpiBf16<0> E{WSP(bf16, WS_PROJ), P_IN, nullptr, 0, 0, 1.f};
            pg8::gemm_phase<pg8::EpiBf16<0>, pg8::StaticOrder, true, true>(F.lds + RING_OFF, g, S, E);
            if (BOTH(pb + 1)) GRID_BAR(pb + 1);
        }
        REP(4) if (PHM(4) && IN(pb + 2)) {
#ifndef NO_ATT
            for (int ra_ = 0; ra_ < 1 + ((REPMASK >> 9) & 1); ++ra_)
            att::attn_phase((char*)lds + RING_OFF, WSP(const bf16, WS_PROJ), WSP(float, WS_O4), WSP(const float, WS_LUT), F.vcu, F.G, C_Q, C_K, C_V);
#endif
#ifndef NO_S5
            for (int rs_ = 0; rs_ < 1 + ((REPMASK >> 10) & 1); ++rs_)
            for (int it = F.vcu; it < BATCH * NGRP; it += F.G)
                s5::s5_unit((char*)lds + RING_OFF, WSP(const bf16, WS_PROJ), WSP(bf16, WS_G), WSP(const char, WS_S5P) + (size_t)(l * NGRP + (it & 127)) * s5::P_BYTES, it >> 7, it & 127);
#endif
            if (BOTH(pb + 2)) GRID_BAR(pb + 2);
        }
        REP(5) if (PHM(5) && IN(pb + 3)) {
            FRESH(); pd_combine(F, WSP(const float, WS_O4), WSP(const bf16, WS_PROJ), in, l, WSP(bf16, WS_YA));
            pg8::Gemm g{WSP(const bf16, WS_G), WSP(const bf16, WS_WT + (size_t)l * WT_LAYER + WT_GLU), M, DSSM, DSSM, P_DS, P_DS}; pg8::StaticOrder S; S.init(M, DSSM, F.G, (int)blockIdx.x);
            pg8::EpiGlu E{WSP(const bf16, WS_G), WSP(const bf16, WS_PROJ), WSP(bf16, WS_YS), C_ZS};
            pg8::gemm_phase<pg8::EpiGlu, pg8::StaticOrder, true, true>(F.lds + RING_OFF, g, S, E);
            if (BOTH(pb + 3)) GRID_BAR(pb + 3);
        }
        REP(6) if (PHM(6) && IN(pb + 4)) {
            { pg8::Gemm g{WSP(const bf16, WS_YS), WSP(const bf16, WS_WT + (size_t)l * WT_LAYER + WT_OS), M, DM, DSSM, P_DS, P_DS}; pg8::StaticOrder S; S.init(M, DM, F.G, (int)blockIdx.x);
              pg8::EpiPs E{WSP(const bf16, WS_PROJ), WSP(bf16, WS_T), C_GS};
              pg8::gemm_phase<pg8::EpiPs, pg8::StaticOrder, true, true>(F.lds + RING_OFF, g, S, E); }
            VM_WAIT(); __syncthreads();
            { pg8::Gemm g{WSP(const bf16, WS_YA), WSP(const bf16, WS_WT + (size_t)l * WT_LAYER + WT_OA), M, DM, DATT, P_DS, P_DS}; pg8::StaticOrder S; S.init(M, DM, F.G, (int)blockIdx.x);
              pg8::EpiPa E{WSP(const bf16, WS_PROJ), WSP(const bf16, WS_T), WSP(bf16, WS_MRG), C_GA};
              pg8::gemm_phase<pg8::EpiPa, pg8::StaticOrder, true, true>(F.lds + RING_OFF, g, S, E); }
            if (BOTH(pb + 4)) GRID_BAR(pb + 4);
        }
        REP(7) if (PHM(7) && IN(pb + 5)) {
            pg8::Gemm g{WSP(const bf16, WS_MRG), WSP(const bf16, WS_WT + (size_t)l * WT_LAYER + WT_O), M, DM, DM, P_DM, P_DM}; pg8::StaticOrder S; S.init(M, DM, F.G, (int)blockIdx.x);
            pg8::EpiRes E{(l == 0) ? INP(I_X) : WSP(const float, WS_H1), (l == 0) ? WSP(float, WS_H1) : opq(args.out), WSP(const float, WS_MOD) + (size_t)l * BATCH * 12288 + 2 * DM, (l == 0) ? DM : P_H1, (l == 0) ? P_H1 : DM};
            pg8::gemm_phase<pg8::EpiRes, pg8::StaticOrder, true, true>(F.lds + RING_OFF, g, S, E);
            if (BOTH(pb + 5)) GRID_BAR(pb + 5);
        }
    }
    if (PHM(8) && IN(14)) { FRESH(); pz_final(F, opq(args.out), INP(I_FING)); }
#ifdef CLOCK_PROBE
    {
        typedef float f32x16p __attribute__((ext_vector_type(16))); typedef short bf16x8p __attribute__((ext_vector_type(8)));
        f32x16p c0 = {}, c1 = {}, c2 = {}, c3 = {}; bf16x8p a = {1, 2, 3, 4, 5, 6, 7, 8}; a[0] = (short)F.tid;
        for (int i = 0; i < CLOCK_PROBE / 4; ++i) {
            c0 = __builtin_amdgcn_mfma_f32_32x32x16_bf16(a, a, c0, 0, 0, 0); c1 = __builtin_amdgcn_mfma_f32_32x32x16_bf16(a, a, c1, 0, 0, 0);
            c2 = __builtin_amdgcn_mfma_f32_32x32x16_bf16(a, a, c2, 0, 0, 0); c3 = __builtin_amdgcn_mfma_f32_32x32x16_bf16(a, a, c3, 0, 0, 0); }
        if (c0[0] + c1[1] + c2[2] + c3[3] == 12345.678f) args.out[0] = 0.f;
    }
#endif
#undef WSP
#undef FRESH
#undef INP
#undef IN
#undef BOTH
#undef GRID_BAR
}

extern "C" void kernel_launch(void* const* d_in, const int* in_sizes, int n_in, void* d_out, int out_size, void* d_ws, size_t ws_size, hipStream_t stream) {
    static int grid = 0;
    if (grid == 0) {
        if (n_in != N_INPUTS || in_sizes[0] != M * DM || out_size != M * DM || ws_size < WS_END) { fprintf(stderr, "kernel_launch: shape mismatch (n_in %d, in0 %d, out %d, ws %zu)\n", n_in, n_in > 0 ? in_sizes[0] : -1, out_size, ws_size); grid = -1; return; }
        int dev = 0, cus = 0, per_cu = 0;
        if (hipGetDevice(&dev) != hipSuccess || hipDeviceGetAttribute(&cus, hipDeviceAttributeMultiprocessorCount, dev) != hipSuccess) { grid = -1; return; }
        if (hipFuncSetAttribute((const void*)hybrid_fwd, hipFuncAttributeMaxDynamicSharedMemorySize, LDS_BYTES) != hipSuccess) { fprintf(stderr, "kernel_launch: hipFuncSetAttribute failed\n"); grid = -1; return; }
        if (hipOccupancyMaxActiveBlocksPerMultiprocessor(&per_cu, (const void*)hybrid_fwd, NWAVES * 64, LDS_BYTES) != hipSuccess || per_cu < 1)
            fprintf(stderr, "kernel_launch: note: occupancy query reports %d workgroups per CU\n", per_cu);
        (void)hipGetLastError();
        grid = cus;
    }
    if (grid < 0) return;
    if (hipMemsetAsync((char*)d_ws + WS_CTL, 0, CTL_ZERO_BYTES, stream) != hipSuccess) { fprintf(stderr, "kernel_launch: hipMemsetAsync failed\n"); return; }
    Args a{};
    for (int i = 0; i < N_INPUTS; ++i) a.in[i] = (const float*)d_in[i];
    a.out = (float*)d_out; a.ws = (unsigned char*)d_ws;
#if MK_SPLIT
    for (int ph = 0; ph < N_PHASES; ++ph) { a.ph_lo = ph; a.ph_hi = ph + 1; hipLaunchKernelGGL(hybrid_fwd, dim3(grid), dim3(NWAVES * 64), LDS_BYTES, stream, a); }
#else
    a.ph_lo = 0; a.ph_hi = N_PHASES;
    hipLaunchKernelGGL(hybrid_fwd, dim3(grid), dim3(NWAVES * 64), LDS_BYTES, stream, a);
#endif
    const hipError_t le = hipPeekAtLastError();
    if (le != hipSuccess) fprintf(stderr, "kernel_launch: launch failed: %s (grid %d)\n", hipGetErrorName(le), grid);
}
```
